# Optimizing an MI355X kernel written in HIP

```python
import jax
import jax.numpy as jnp
from jax import lax
import numpy as np

D_MODEL = 1024
BATCH = 2
SEQ = 8192
DEPTH = 1
DEC_BATCH = 128
DEC_SEQ = 8
PAST_LEN = 2048
PAGE_SIZE = 128

HG_DK = 128
HG_DV = 128
HG_HEADS = D_MODEL // 128
HG_W = HG_HEADS * HG_DV
HG_CHUNK = 64
NSA_HD = 64
NSA_HEADS = D_MODEL // NSA_HD
NSA_KV = 4
NSA_GROUP = NSA_HEADS // NSA_KV
NSA_W = NSA_HEADS * NSA_HD
KV_W = NSA_KV * NSA_HD
CMP_D = 16
CMP_L = 2 * CMP_D
CMP_HID = 2 * NSA_HD
SLC_L = 64
N_SEL = 16
WINDOW = 512
MEM_TOKENS = 256
MEM_HEADS = 4
MEM_HD = D_MODEL // MEM_HEADS
D_FF = 4 * D_MODEL
ROPE_THETA = 10000.0
LN_EPS = 1e-5
RMS_EPS = 1e-6
DN_ALPHA = (2.0 * DEPTH) ** 0.25
DN_BETA = (8.0 * DEPTH) ** -0.25
ATT_SCALE = NSA_HD ** -0.5
MEM_SCALE = MEM_HD ** -0.5
IN_SIZES = (HG_W, HG_W, HG_W, HG_W, NSA_W, 6 * KV_W, 3 * NSA_HEADS, D_MODEL, D_MODEL)

kernel_name = 'hgrn2_nsa_gated_hybrid_step'


def _pick_block(n, cap):
    b = max(1, min(n, cap))
    while n % b:
        b -= 1
    return b


def _layer_norm(x, g, b):
    xf = x.astype(jnp.float32)
    mu = jnp.mean(xf, axis=-1, keepdims=True)
    var = jnp.mean(jnp.square(xf - mu), axis=-1, keepdims=True)
    return ((xf - mu) * lax.rsqrt(var + LN_EPS) * g.astype(jnp.float32) + b.astype(jnp.float32)).astype(x.dtype)


def _post(x, sub, g, b):
    return _layer_norm(DN_ALPHA * x + sub, g, b)


def _rope(x, pos):
    half = x.shape[-1] // 2
    inv = ROPE_THETA ** (-jnp.arange(half, dtype=jnp.float32) / half)
    ang = jnp.asarray(pos, jnp.float32)[:, None] * inv[None, :]
    cos = jnp.cos(ang)[None, :, None, :]
    sin = jnp.sin(ang)[None, :, None, :]
    xf = x.astype(jnp.float32)
    x1, x2 = xf[..., :half], xf[..., half:]
    return jnp.concatenate([x1 * cos - x2 * sin, x2 * cos + x1 * sin], axis=-1).astype(x.dtype)


def _masked_softmax(s, mask):
    s = jnp.where(mask, s.astype(jnp.float32), -jnp.inf)
    m = jnp.max(s, axis=-1, keepdims=True)
    m = jnp.where(jnp.isfinite(m), m, 0.0)
    e = jnp.exp(s - m)
    return e / jnp.maximum(jnp.sum(e, axis=-1, keepdims=True), 1e-30)


def _split_in(proj):
    cuts = np.cumsum(np.array(IN_SIZES))[:-1].tolist()
    return jnp.split(proj, cuts, axis=-1)


def _gather_pages(pool, page_table):
    g = pool[page_table]
    return g.reshape((page_table.shape[0], page_table.shape[1] * pool.shape[1]) + pool.shape[2:])


def _hgrn2_scan(q, k, v, g, s0):
    B, L, H, DK = q.shape
    DV = v.shape[-1]
    C = _pick_block(L, HG_CHUNK)
    n = L // C

    def chunks(a):
        return a.reshape(B, n, C, H, a.shape[-1]).swapaxes(0, 1)

    causal = jnp.tril(jnp.ones((C, C), dtype=bool))

    def step(S, inp):
        qc, kc, vc, gc = inp
        G = jnp.cumsum(gc, axis=1)
        o_inter = jnp.einsum('bthk,bhkv->bthv', qc * jnp.exp(G), S)
        diff = G[:, :, None] - G[:, None, :]
        decay = jnp.exp(jnp.where(causal[None, :, :, None, None], diff, -jnp.inf))
        A = jnp.einsum('bthk,btshk,bshk->bths', qc, decay, kc)
        o_intra = jnp.einsum('bths,bshv->bthv', A, vc)
        G_last = G[:, -1]
        k_dec = kc * jnp.exp(G_last[:, None] - G)
        S = S * jnp.exp(G_last)[..., None] + jnp.einsum('bshk,bshv->bhkv', k_dec, vc)
        return S, o_inter + o_intra

    S, o = lax.scan(step, s0, (chunks(q), chunks(k), chunks(v), chunks(g)))
    return o.swapaxes(0, 1).reshape(B, L, H, DV), S


def _hgrn2(hq, hf, hi, hog, lb, gnorm, s0):
    B, L, _ = hq.shape
    f32 = jnp.float32
    shp = (B, L, HG_HEADS, HG_DK)
    q = jax.nn.silu(hq.astype(f32)).reshape(shp)
    forget = lb + (1.0 - lb) * jax.nn.sigmoid(hf.astype(f32))
    k = (1.0 - forget).reshape(shp)
    g = jnp.log(forget).reshape(shp)
    v = hi.astype(f32).reshape(B, L, HG_HEADS, HG_DV)
    o, s_new = _hgrn2_scan(q, k, v, g, s0.astype(f32))
    o = o * lax.rsqrt(jnp.mean(o * o, axis=-1, keepdims=True) + RMS_EPS) * gnorm.astype(f32)
    o = o.reshape(B, L, HG_W) * jax.nn.silu(hog.astype(f32))
    return o.astype(hq.dtype), s_new.astype(hq.dtype)


def _compress(rows, pe, w1, w2):
    B, T = rows.shape[:2]
    n_full = T // CMP_D
    ch = rows[:, :n_full * CMP_D].reshape(B, n_full, CMP_D, NSA_KV, NSA_HD)
    first = jnp.einsum('bnlkd,ldh->bnkh', ch, w1[:CMP_D])
    second = jnp.einsum('bnlkd,ldh->bnkh', ch, w1[CMP_D:])
    pos_bias = jnp.einsum('ld,ldh->h', pe, w1)
    return jax.nn.gelu(first[:, :-1] + second[:, 1:] + pos_bias) @ w2


def _nsa_cmp_slc(q, q_rot, cmp_all, slc_all, pos, cmp_pe, cmp_w1, cmp_w2):
    B, L = q.shape[:2]
    T = cmp_all.shape[1]
    kc = _compress(cmp_all[:, :, 0], cmp_pe[0], cmp_w1[0], cmp_w2[0])
    vc = _compress(cmp_all[:, :, 1], cmp_pe[1], cmp_w1[1], cmp_w2[1])
    n_cmp = kc.shape[1]
    n_slc = -(-T // SLC_L)
    n_sel = min(N_SEL, n_slc)
    blk_end = jnp.asarray(np.arange(n_cmp) * CMP_D + CMP_L - 1)
    i0 = np.arange(n_cmp)[:, None] * CMP_D
    j0 = np.arange(n_slc)[None, :] * SLC_L
    inc = jnp.asarray(((i0 < j0 + SLC_L) & (i0 + CMP_L > j0)).astype(np.float32))
    pad = n_slc * SLC_L - T
    slc_p = jnp.pad(slc_all, ((0, 0), (0, pad), (0, 0), (0, 0), (0, 0)))
    kb = slc_p[:, :, 0].reshape(B, n_slc, SLC_L, NSA_KV, NSA_HD).transpose(0, 3, 1, 2, 4)
    vb = slc_p[:, :, 1].reshape(B, n_slc, SLC_L, NSA_KV, NSA_HD).transpose(0, 3, 1, 2, 4)
    QB = _pick_block(L, max(1, 128 // B))
    nq = L // QB

    def blocks(a):
        return a.reshape(B, nq, QB, NSA_KV, NSA_GROUP, NSA_HD).swapaxes(0, 1)

    bi = jnp.arange(B)[:, None, None, None]
    ki = jnp.arange(NSA_KV)[None, :, None, None]
    blk_ids = jnp.arange(n_slc)

    def one(args):
        qc, qr, pb = args
        s_c = jnp.einsum('bqkgd,bnkd->bkgqn', qc, kc) * ATT_SCALE
        pr = _masked_softmax(s_c, blk_end[None, :] <= pb[:, None])
        o_c = jnp.einsum('bkgqn,bnkd->bqkgd', pr.astype(vc.dtype), vc)
        p_slc = jnp.einsum('bkgqn,nj->bkqj', pr, inc)
        cur = pb // SLC_L
        valid = blk_ids[None, :] <= cur[:, None]
        forced = (blk_ids[None, :] == 0) | (blk_ids[None, :] == cur[:, None]) | (blk_ids[None, :] == cur[:, None] - 1)
        score = jnp.where(forced, 1e9, jnp.where(valid, p_slc, -1.0))
        _, idx = lax.top_k(score, n_sel)
        kg = kb[bi, ki, idx]
        vg = vb[bi, ki, idx]
        s_s = jnp.einsum('bqkgd,bkqsld->bkgqsl', qr, kg) * ATT_SCALE
        k_pos = idx[..., None] * SLC_L + jnp.arange(SLC_L)
        m_s = k_pos <= pb[None, None, :, None, None]
        pr_s = _masked_softmax(s_s.reshape(B, NSA_KV, NSA_GROUP, QB, n_sel * SLC_L),
                               m_s.reshape(B, NSA_KV, 1, QB, n_sel * SLC_L))
        o_s = jnp.einsum('bkgqn,bkqnd->bqkgd', pr_s.astype(vg.dtype), vg.reshape(B, NSA_KV, QB, n_sel * SLC_L, NSA_HD))
        return o_c, o_s

    o_c, o_s = lax.map(one, (blocks(q), blocks(q_rot), jnp.asarray(pos, jnp.int32).reshape(nq, QB)))
    o_c = o_c.swapaxes(0, 1).reshape(B, L, NSA_HEADS, NSA_HD)
    o_s = o_s.swapaxes(0, 1).reshape(B, L, NSA_HEADS, NSA_HD)
    return o_c, o_s


def _win_banded(q, kv):
    B, L = q.shape[:2]
    WB = _pick_block(L, 128)
    nb = L // WB
    span = WINDOW + WB
    kvp = jnp.pad(kv, ((0, 0), (WINDOW, 0), (0, 0), (0, 0), (0, 0)))
    qb = q.reshape(B, nb, WB, NSA_KV, NSA_GROUP, NSA_HD).swapaxes(0, 1)

    def one(args):
        qc, start = args
        kvc = lax.dynamic_slice_in_dim(kvp, start, span, axis=1)
        s = jnp.einsum('bqkgd,bskd->bkgqs', qc, kvc[:, :, 0]) * ATT_SCALE
        q_pos = start + jnp.arange(WB)
        k_pos = start - WINDOW + jnp.arange(span)
        mask = (k_pos[None, :] <= q_pos[:, None]) & (k_pos[None, :] > q_pos[:, None] - WINDOW)
        pr = _masked_softmax(s, mask)
        return jnp.einsum('bkgqs,bskd->bqkgd', pr.astype(kvc.dtype), kvc[:, :, 1])

    o = lax.map(one, (qb, jnp.arange(nb, dtype=jnp.int32) * WB))
    return o.swapaxes(0, 1).reshape(B, L, NSA_HEADS, NSA_HD)


def _win_dense(q, kv, q_pos, k_pos):
    B, L = q.shape[:2]
    qg = q.reshape(B, L, NSA_KV, NSA_GROUP, NSA_HD)
    s = jnp.einsum('bqkgd,bskd->bkgqs', qg, kv[:, :, 0]) * ATT_SCALE
    mask = (k_pos[None, :] <= q_pos[:, None]) & (k_pos[None, :] > q_pos[:, None] - WINDOW)
    pr = _masked_softmax(s, jnp.asarray(mask))
    o = jnp.einsum('bkgqs,bskd->bqkgd', pr.astype(kv.dtype), kv[:, :, 1])
    return o.reshape(B, L, NSA_HEADS, NSA_HD)


def _mix(u, pos, lb, hg_s0, cmp_past, slc_past, win_past, w_in, w_out, hg_gnorm, cmp_pe, cmp_w1, cmp_w2):
    B, L, _ = u.shape
    hq, hf, hi, hog, nq, nkv, ngate, gate_a, gate_b = _split_in(u @ w_in)
    o_hg, s_new = _hgrn2(hq, hf, hi, hog, lb, hg_gnorm, hg_s0)
    q = nq.reshape(B, L, NSA_HEADS, NSA_HD)
    q_rot = _rope(q, pos)
    kv = nkv.reshape(B, L, 3, 2, NSA_KV, NSA_HD)
    cmp_new = kv[:, :, 0]
    slc_new = jnp.stack([_rope(kv[:, :, 1, 0], pos), kv[:, :, 1, 1]], axis=2)
    win_new = jnp.stack([_rope(kv[:, :, 2, 0], pos), kv[:, :, 2, 1]], axis=2)
    if cmp_past is None:
        cmp_all, slc_all = cmp_new, slc_new
        o_win = _win_banded(q_rot, win_new)
        win_state = win_new[:, L - min(WINDOW, L):]
    else:
        cmp_all = jnp.concatenate([cmp_past, cmp_new], axis=1)
        slc_all = jnp.concatenate([slc_past, slc_new], axis=1)
        n_buf = win_past.shape[1]
        win_all = jnp.concatenate([win_past, win_new], axis=1)
        k_pos = pos[0] - n_buf + np.arange(n_buf + L)
        o_win = _win_dense(q_rot, win_all, pos, k_pos)
        win_state = win_all[:, L:]
    o_cmp, o_slc = _nsa_cmp_slc(q, q_rot, cmp_all, slc_all, pos, cmp_pe, cmp_w1, cmp_w2)
    g = jax.nn.sigmoid(ngate).reshape(B, L, 3, NSA_HEADS, 1)
    o_nsa = (g[:, :, 0] * o_cmp + g[:, :, 1] * o_slc + g[:, :, 2] * o_win).reshape(B, L, NSA_W).astype(u.dtype)
    merged = jax.nn.sigmoid(gate_a) * o_hg + jax.nn.sigmoid(gate_b) * o_nsa
    return merged @ w_out, (s_new, cmp_new, slc_new, win_state)


def _mem_kv(mem, w_mkv):
    B, M, _ = mem.shape
    return (mem @ w_mkv).reshape(B, M, 2, MEM_HEADS, MEM_HD)


def _mem_attend(x, mkv, w_mq, w_mo):
    B, L, _ = x.shape
    q = (x @ w_mq).reshape(B, L, MEM_HEADS, MEM_HD)
    s = jnp.einsum('bqhd,bmhd->bhqm', q, mkv[:, :, 0]) * MEM_SCALE
    pr = jax.nn.softmax(s.astype(jnp.float32), axis=-1)
    o = jnp.einsum('bhqm,bmhd->bqhd', pr.astype(mkv.dtype), mkv[:, :, 1])
    return o.reshape(B, L, D_MODEL) @ w_mo


def _mlp(x, w_up, w_down):
    h = jax.nn.relu(x @ w_up)
    return (h * h) @ w_down


def setup_inputs(seed: int = 0) -> dict:
    key = jax.random.key(seed)
    ks = jax.random.split(key, 23)
    f32 = jnp.float32
    n_pages = PAST_LEN // PAGE_SIZE
    n_used = DEC_BATCH * n_pages
    n_phys = n_used + (n_used + 3) // 4
    win_buf = min(WINDOW, PAST_LEN)
    n_in = sum(IN_SIZES)

    def nrm(k, shape, scale):
        return jax.random.normal(k, shape, f32) * scale

    page_table = jax.random.permutation(ks[7], n_phys)[:n_used].reshape(DEC_BATCH, n_pages).astype(jnp.int32)
    return {
        'x_prompt': nrm(ks[0], (BATCH, SEQ, D_MODEL), 1.0),
        'x_sample': nrm(ks[1], (DEC_BATCH, DEC_SEQ, D_MODEL), 1.0),
        'state_hgrn': nrm(ks[2], (DEPTH, DEC_BATCH, HG_HEADS, HG_DK, HG_DV), 0.5),
        'cache_cmp_kv': nrm(ks[3], (DEPTH, n_phys, PAGE_SIZE, 2, NSA_KV, NSA_HD), 1.0),
        'cache_slc_kv': nrm(ks[4], (DEPTH, n_phys, PAGE_SIZE, 2, NSA_KV, NSA_HD), 1.0),
        'cache_win_kv': nrm(ks[5], (DEPTH, DEC_BATCH, win_buf, 2, NSA_KV, NSA_HD), 1.0),
        'cache_mem_kv': nrm(ks[6], (DEPTH, DEC_BATCH, MEM_TOKENS, 2, MEM_HEADS, MEM_HD), 1.0),
        'page_table': page_table,
        'mem_prompt': nrm(ks[8], (BATCH, MEM_TOKENS, D_MODEL), 1.0),
        'w_in': nrm(ks[9], (DEPTH, D_MODEL, n_in), D_MODEL ** -0.5),
        'w_out': nrm(ks[10], (DEPTH, D_MODEL, D_MODEL), DN_BETA * D_MODEL ** -0.5),
        'hg_lb': nrm(ks[11], (DEPTH + 1, HG_W), 0.5),
        'hg_gnorm': 1.0 + nrm(ks[12], (DEPTH, HG_DV), 0.02),
        'cmp_pe': nrm(ks[13], (DEPTH, 2, CMP_L, NSA_HD), 0.02),
        'cmp_w1': nrm(ks[14], (DEPTH, 2, CMP_L, NSA_HD, CMP_HID), (CMP_L * NSA_HD) ** -0.5),
        'cmp_w2': nrm(ks[15], (DEPTH, 2, CMP_HID, NSA_HD), CMP_HID ** -0.5),
        'w_mq': nrm(ks[16], (DEPTH, D_MODEL, D_MODEL), D_MODEL ** -0.5),
        'w_mkv': nrm(ks[17], (DEPTH, D_MODEL, 2 * D_MODEL), D_MODEL ** -0.5),
        'w_mo': nrm(ks[18], (DEPTH, D_MODEL, D_MODEL), DN_BETA * D_MODEL ** -0.5),
        'w_up': nrm(ks[19], (DEPTH, D_MODEL, D_FF), D_MODEL ** -0.5),
        'w_down': nrm(ks[20], (DEPTH, D_FF, D_MODEL), DN_BETA * D_FF ** -0.5),
        'ln_g': 1.0 + nrm(ks[21], (DEPTH, 3, D_MODEL), 0.02),
        'ln_b': nrm(ks[22], (DEPTH, 3, D_MODEL), 0.02),
    }


def reference(x_prompt, x_sample, state_hgrn, cache_cmp_kv, cache_slc_kv, cache_win_kv, cache_mem_kv,
              page_table, mem_prompt, w_in, w_out, hg_lb, hg_gnorm, cmp_pe, cmp_w1, cmp_w2,
              w_mq, w_mkv, w_mo, w_up, w_down, ln_g, ln_b):
    pos_p = np.arange(x_prompt.shape[1])
    pos_s = PAST_LEN + np.arange(x_sample.shape[1])
    lb_all = jnp.cumsum(jax.nn.softmax(hg_lb.astype(jnp.float32), axis=0), axis=0)
    xp, xs = x_prompt, x_sample
    B = x_prompt.shape[0]
    hp, cp, sp, wp, mp = [], [], [], [], []
    hs, cs, ss, ws = [], [], [], []
    for l in range(DEPTH):
        mix_p, (h_n, c_n, s_n, w_n) = _mix(xp, pos_p, lb_all[l], jnp.zeros((B, HG_HEADS, HG_DK, HG_DV), jnp.float32),
                                           None, None, None, w_in[l], w_out[l], hg_gnorm[l], cmp_pe[l], cmp_w1[l], cmp_w2[l])
        xp = _post(xp, mix_p, ln_g[l, 0], ln_b[l, 0])
        mkv_p = _mem_kv(mem_prompt, w_mkv[l])
        xp = _post(xp, _mem_attend(xp, mkv_p, w_mq[l], w_mo[l]), ln_g[l, 1], ln_b[l, 1])
        xp = _post(xp, _mlp(xp, w_up[l], w_down[l]), ln_g[l, 2], ln_b[l, 2])
        hp.append(h_n); cp.append(c_n); sp.append(s_n); wp.append(w_n); mp.append(mkv_p)
        cmp_past = _gather_pages(cache_cmp_kv[l], page_table)
        slc_past = _gather_pages(cache_slc_kv[l], page_table)
        mix_s, (h_n, c_n, s_n, w_n) = _mix(xs, pos_s, lb_all[l], state_hgrn[l], cmp_past, slc_past, cache_win_kv[l],
                                           w_in[l], w_out[l], hg_gnorm[l], cmp_pe[l], cmp_w1[l], cmp_w2[l])
        xs = _post(xs, mix_s, ln_g[l, 0], ln_b[l, 0])
        xs = _post(xs, _mem_attend(xs, cache_mem_kv[l], w_mq[l], w_mo[l]), ln_g[l, 1], ln_b[l, 1])
        xs = _post(xs, _mlp(xs, w_up[l], w_down[l]), ln_g[l, 2], ln_b[l, 2])
        hs.append(h_n); cs.append(c_n); ss.append(s_n); ws.append(w_n)
    p_state_hgrn = jnp.stack(hp)
    p_cmp_kv = jnp.stack(cp)
    p_slc_kv = jnp.stack(sp)
    p_win_kv = jnp.stack(wp)
    p_mem_kv = jnp.stack(mp)
    s_state_hgrn = jnp.stack(hs)
    s_cmp_kv = jnp.stack(cs)
    s_slc_kv = jnp.stack(ss)
    s_win_kv = jnp.stack(ws)
    return (xp, xs, p_state_hgrn, p_cmp_kv, p_slc_kv, p_win_kv, p_mem_kv, s_state_hgrn, s_cmp_kv, s_slc_kv, s_win_kv)
```

```cpp
#include <hip/hip_runtime.h>
#include <stdint.h>
#include <stdio.h>

#define LAS __attribute__((address_space(3)))
typedef unsigned short bf16_t;
typedef short bf16x8 __attribute__((ext_vector_type(8)));
typedef short bf16x4 __attribute__((ext_vector_type(4)));
typedef float f32x4 __attribute__((ext_vector_type(4)));
typedef float f32x2 __attribute__((ext_vector_type(2)));
typedef unsigned u32x4 __attribute__((ext_vector_type(4)));
typedef unsigned u32x2 __attribute__((ext_vector_type(2)));

constexpr int DM = 1024, SEQ = 8192, NBATCH = 2, MP = NBATCH * SEQ, DBATCH = 128, DSEQ = 8, MS = DBATCH * DSEQ, MT = MP + MS;
constexpr int PAST = 2048, PAGE = 128, NPAGES = PAST / PAGE, WIN = 512, MEMT = 256;
constexpr int NIN = 8752, NINP = 8960, DFF = 4096;
constexpr int NCMP_P = SEQ / 16 - 1  , NCMP_S = PAST / 16 - 1  ;
constexpr float LN_EPS = 1e-5f, RMS_EPS = 1e-6f;
constexpr float DN_ALPHA = 1.18920711500272f;
constexpr size_t OFF_Y = 0, OFF_PSTATE = 17825792, OFF_PCMP = 18087936, OFF_PSLC = 26476544, OFF_PWIN = 34865152, OFF_PMEM = 35389440,
                 OFF_SSTATE = 36438016, OFF_SCMP = 53215232, OFF_SSLC = 53739520, OFF_SWIN = 54263808;

__device__ __forceinline__ float bf2f(bf16_t v) { return __uint_as_float((unsigned)v << 16); }
typedef __bf16 bf16x2_t __attribute__((ext_vector_type(2)));
__device__ __forceinline__ unsigned cvt_pk_bf16(float lo, float hi) { const f32x2 v = {lo, hi}; return __builtin_bit_cast(unsigned, __builtin_convertvector(v, bf16x2_t)); }
__device__ __forceinline__ bf16_t f2bf(float f) { return (bf16_t)(cvt_pk_bf16(f, 0.f) & 0xffffu); }
__device__ __forceinline__ float fast_exp(float x) { return __builtin_amdgcn_exp2f(x * 1.44269504088896f); }
__device__ __forceinline__ float sigmoidf_(float x) { return __builtin_amdgcn_rcpf(1.0f + fast_exp(-x)); }
__device__ __forceinline__ float siluf_(float x) { return x * sigmoidf_(x); }
__device__ __forceinline__ float lo_bf(unsigned w) { return __uint_as_float(w << 16); }
__device__ __forceinline__ float hi_bf(unsigned w) { return __uint_as_float(w & 0xffff0000u); }
__device__ __forceinline__ u32x4 pack8(const f32x4 a, const f32x4 b) { u32x4 o; o.x = cvt_pk_bf16(a[0], a[1]); o.y = cvt_pk_bf16(a[2], a[3]); o.z = cvt_pk_bf16(b[0], b[1]); o.w = cvt_pk_bf16(b[2], b[3]); return o; }
namespace pg8 {
#define PG8_LAS __attribute__((address_space(3)))
typedef unsigned short bf16_t;
typedef short bf16x8 __attribute__((ext_vector_type(8)));
typedef float f32x4 __attribute__((ext_vector_type(4)));
typedef unsigned u32x4 __attribute__((ext_vector_type(4)));
constexpr int BM = 256, BK = 64, HALF = 128, HTB = HALF * BK * 2  , STAGE_BYTES = 8 * HTB, NXCD = 8, WGM = 8;

__host__ __device__ __forceinline__ int lds_byte(int r, int c) { const int st = (r >> 4) * 2 + (c >> 5), rr = r & 15, cc = c & 31, ob = rr * 64 + cc * 2; return st * 1024 + (ob ^ (((ob >> 9) & 1) << 5)); }
__host__ __device__ __forceinline__ void stage_rc(int b, int& R, int& C) { const int st = b / 1024, sb = b % 1024, swz = sb ^ (((sb >> 9) & 1) << 5); R = (st >> 1) * 16 + swz / 64; C = (st & 1) * 32 + (swz % 64) / 2; }
__host__ __device__ __forceinline__ int perm32(int rho) { const int n = rho >> 4, i = rho & 15; return 8 * (i >> 2) + 4 * n + (i & 3); }

struct Unit { int pm, pn; };
struct Gemm { const bf16_t* A; const bf16_t* Bt; int M, N, K, lda; };
struct StaticOrder {
    int nM, nN, nwg, G, c;
    __host__ __device__ void init(int M, int N, int G_, int c_) { nM = M / BM; nN = N / BM; nwg = nM * nN; G = G_; c = c_; }
    __host__ __device__ bool next(int i, Unit& u) const {
        const long L = (long)i * G + c; if (L >= nwg) return false;
        int wgid = (int)L; { const int q = nwg / NXCD, r = nwg % NXCD, xcd = wgid % NXCD, off = wgid / NXCD; wgid = (xcd < r ? xcd * (q + 1) : r * (q + 1) + (xcd - r) * q) + off; }
        const int nig = WGM * nN, gid = wgid / nig, fm = gid * WGM, gsz = (nM - fm) < WGM ? (nM - fm) : WGM;
        u.pm = fm + ((wgid % nig) % gsz); u.pn = (wgid % nig) / gsz; return true;
    }
    __device__ __forceinline__ void a_ready(const Unit&) const {}
    __device__ __forceinline__ void done(const Unit&) const {}
};
template <class Epi, class Sched, bool STAMP = false>
__device__ __forceinline__ void gemm_phase(PG8_LAS unsigned char* lds, const Gemm g, const Sched& S, const Epi& E, unsigned long long* stamps) {
    const int tid = threadIdx.x, wid = __builtin_amdgcn_readfirstlane(tid >> 6), lane = tid & 63, wr = wid >> 2, wc = wid & 3, fr = lane & 15, fq = lane >> 4;
    const int K = g.K, nt = K / BK;
    int ts_lo = 0, ts_hi = 0, nts = 0; const unsigned long long rt_entry = STAMP ? (unsigned long long)wall_clock64() : 0ull;
#define PG8_STAMP() do { if (STAMP && wid == 0 && nts < 64) { const unsigned long long _c = (unsigned long long)clock64(); \
        ts_lo = (lane == nts) ? (int)(unsigned)_c : ts_lo; ts_hi = (lane == nts) ? (int)(unsigned)(_c >> 32) : ts_hi; ++nts; } } while (0)
    PG8_STAMP();
    unsigned voffA[2], voffB[2];
#pragma unroll
    for (int i = 0; i < 2; ++i) { int R, C; stage_rc(tid * 16 + i * 8192, R, C); const int Rb = Epi::PERM ? ((R & ~31) + perm32(R & 31)) : R;
        voffA[i] = (unsigned)(R * g.lda + C) * 2u; voffB[i] = (unsigned)(Rb * K + C) * 2u; }
    const size_t kstep = (size_t)(BK * 2);
    const size_t hstep = (size_t)HALF * K * 2, hstepA = (size_t)HALF * g.lda * 2;
    const size_t tstep = 2 * hstep, tstepA = 2 * hstepA;
    const unsigned ldsw = (unsigned)wid * 1024u;
    const int aoff = lds_byte(wr * 64 + fr, fq * 8), boff = lds_byte(wc * 32 + fr, fq * 8);
#define PG8_SA(b, h) (((b) * 2 + (h)) * HTB)
#define PG8_SB(b, h) ((4 + (b) * 2 + (h)) * HTB)
#define PG8_STAGE(bufoff, gbase, voff) do { _Pragma("unroll") for (int _i = 0; _i < 2; ++_i) \
        __builtin_amdgcn_global_load_lds((const unsigned*)((const char*)(gbase) + (voff)[_i]), (PG8_LAS unsigned*)(lds + (bufoff) + ldsw + _i * 8192), 16, 0, 0); } while (0)
#define PG8_LDA(dst, b, h) do { _Pragma("unroll") for (int m = 0; m < 4; ++m) _Pragma("unroll") for (int k = 0; k < 2; ++k) dst[m][k] = *(const PG8_LAS bf16x8*)(lds + PG8_SA(b, h) + aoff + m * 2048 + k * 1024); } while (0)
#define PG8_LDB(dst, b, h) do { _Pragma("unroll") for (int n = 0; n < 2; ++n) _Pragma("unroll") for (int k = 0; k < 2; ++k) dst[n][k] = *(const PG8_LAS bf16x8*)(lds + PG8_SB(b, h) + boff + n * 2048 + k * 1024); } while (0)
#define PG8_MMA(ai, bj, At, Bt) do { __builtin_amdgcn_s_setprio(1); _Pragma("unroll") for (int m = 0; m < 4; ++m) _Pragma("unroll") for (int n = 0; n < 2; ++n) _Pragma("unroll") for (int k = 0; k < 2; ++k) \
        acc[ai][bj][m][n] = __builtin_amdgcn_mfma_f32_16x16x32_bf16(Bt[n][k], At[m][k], acc[ai][bj][m][n], 0, 0, 0); __builtin_amdgcn_s_setprio(0); } while (0)
#define PG8_WAIT_V(n) asm volatile("s_waitcnt vmcnt(" #n ")" ::: "memory")
#define PG8_WAIT_L(n) asm volatile("s_waitcnt lgkmcnt(" #n ")" ::: "memory")
#define PG8_BAR __builtin_amdgcn_s_barrier()
#define PG8_SCHED __builtin_amdgcn_sched_barrier(0)
    Unit cur, nxt; int ui = 0;
    if (!S.next(0, cur)) return;
    f32x4 acc[2][2][4][2];
#pragma unroll
    for (int a = 0; a < 2; ++a)
#pragma unroll
        for (int b = 0; b < 2; ++b)
#pragma unroll
            for (int m = 0; m < 4; ++m)
#pragma unroll
                for (int n = 0; n < 2; ++n) acc[a][b][m][n] = (f32x4){0.f, 0.f, 0.f, 0.f};
    bf16x8 At[4][2], B0[2][2], B1[2][2];
    const char* cA = (const char*)g.A + (size_t)cur.pm * tstepA; const char* cB = (const char*)g.Bt + (size_t)cur.pn * tstep;
    S.a_ready(cur);
    PG8_STAGE(PG8_SB(0, 0), cB, voffB); PG8_STAGE(PG8_SA(0, 0), cA, voffA); PG8_STAGE(PG8_SB(0, 1), cB + hstep, voffB); PG8_STAGE(PG8_SA(0, 1), cA + hstepA, voffA);
    if (wr == 1) PG8_BAR;
    PG8_WAIT_V(4); PG8_BAR;
    PG8_STAGE(PG8_SB(1, 0), cB + kstep, voffB); PG8_STAGE(PG8_SA(1, 0), cA + kstep, voffA); PG8_STAGE(PG8_SB(1, 1), cB + hstep + kstep, voffB);
    PG8_WAIT_V(6); PG8_BAR;
    PG8_STAMP();
    for (;;) {
        const bool has_next = S.next(ui + 1, nxt);
        const char* nA = has_next ? (const char*)g.A + (size_t)nxt.pm * tstepA : cA; const char* nB = has_next ? (const char*)g.Bt + (size_t)nxt.pn * tstep : cB;
        for (int t = 0; t < nt; t += 2) {
            const bool last = (t == nt - 2);
            const char* a1 = cA + (size_t)(t + 1) * kstep;
            const char* a2 = last ? nA : cA + (size_t)(t + 2) * kstep; const char* b2 = last ? nB : cB + (size_t)(t + 2) * kstep;
            const char* a3 = a2 + kstep; const char* b3 = b2 + kstep;
            if (last && has_next) S.a_ready(nxt);
            PG8_LDB(B0, 0, 0); PG8_SCHED; PG8_LDA(At, 0, 0); PG8_STAGE(PG8_SA(1, 1), a1 + hstepA, voffA);
            PG8_WAIT_L(8); PG8_BAR; PG8_WAIT_L(0); PG8_MMA(0, 0, At, B0); PG8_BAR; PG8_SCHED;
            PG8_LDB(B1, 0, 1); PG8_STAGE(PG8_SB(0, 0), b2, voffB);
            PG8_BAR; PG8_WAIT_L(0); PG8_MMA(0, 1, At, B1); PG8_BAR;
            PG8_LDA(At, 0, 1); PG8_STAGE(PG8_SA(0, 0), a2, voffA);
            PG8_BAR; PG8_WAIT_L(0); PG8_MMA(1, 0, At, B0); PG8_BAR; PG8_SCHED;
            PG8_STAGE(PG8_SB(0, 1), b2 + hstep, voffB);
            PG8_WAIT_V(6); PG8_BAR; PG8_MMA(1, 1, At, B1); PG8_BAR;
            PG8_LDB(B0, 1, 0); PG8_SCHED; PG8_LDA(At, 1, 0); PG8_STAGE(PG8_SA(0, 1), a2 + hstepA, voffA);
            PG8_WAIT_L(8); PG8_BAR; PG8_WAIT_L(0); PG8_MMA(0, 0, At, B0); PG8_BAR; PG8_SCHED;
            PG8_LDB(B1, 1, 1); PG8_STAGE(PG8_SB(1, 0), b3, voffB);
            PG8_BAR; PG8_WAIT_L(0); PG8_MMA(0, 1, At, B1); PG8_BAR;
            PG8_LDA(At, 1, 1); PG8_STAGE(PG8_SA(1, 0), a3, voffA);
            PG8_BAR; PG8_WAIT_L(0); PG8_MMA(1, 0, At, B0); PG8_BAR; PG8_SCHED;
            PG8_STAGE(PG8_SB(1, 1), b3 + hstep, voffB);
            PG8_WAIT_V(6); PG8_BAR; PG8_MMA(1, 1, At, B1); PG8_BAR;
        }
        PG8_STAMP();
        if constexpr (!Epi::AFTER_DRAIN) { E(acc, cur, wr, wc, fr, fq); S.done(cur); }
        PG8_STAMP();
        if (!has_next) break;
#pragma unroll
        for (int a = 0; a < 2; ++a)
#pragma unroll
            for (int b = 0; b < 2; ++b)
#pragma unroll
                for (int m = 0; m < 4; ++m)
#pragma unroll
                    for (int n = 0; n < 2; ++n) acc[a][b][m][n] = (f32x4){0.f, 0.f, 0.f, 0.f};
        cur = nxt; cA = nA; cB = nB; ++ui;
    }
    PG8_WAIT_V(0);
    if (wr == 0) PG8_BAR;
    PG8_BAR;
    if constexpr (Epi::AFTER_DRAIN) { E.fused(acc, cur, wr, wc, fr, fq, lds, wid, lane); S.done(cur); }
    PG8_STAMP();
    if (STAMP && wid == 0) { stamps[lane] = lane < nts ? (((unsigned long long)(unsigned)ts_hi << 32) | (unsigned)ts_lo) : 0ull;
        if (lane == 62) stamps[62] = rt_entry; if (lane == 63) stamps[63] = (unsigned long long)wall_clock64(); }
#undef PG8_STAMP
#undef PG8_SA
#undef PG8_SB
#undef PG8_STAGE
#undef PG8_LDA
#undef PG8_LDB
#undef PG8_MMA
#undef PG8_WAIT_V
#undef PG8_WAIT_L
#undef PG8_BAR
#undef PG8_SCHED
}
}
struct Params {
    const float *x_prompt, *x_sample, *state_hgrn, *cache_cmp, *cache_slc, *cache_win, *cache_mem;
    const int* page_table;
    const float *mem_prompt, *w_in, *w_out, *hg_lb, *hg_gnorm, *cmp_pe, *cmp_w1, *cmp_w2, *w_mq, *w_mkv, *w_mo, *w_up, *w_down, *ln_g, *ln_b;
    float* out;
    unsigned* bar; float *stats1, *stats2, *stats3, *cs_mq, *bw_mq, *cs_up, *bw_up, *posb;
    bf16_t *Wt_in, *Wt_out, *Wt_mq, *Wt_mkv, *Wt_mo, *Wt_up, *Wt_down, *W1t, *W2t;
    float *lbv, *rope;
    bf16_t *Xb, *Memb, *HQ, *HV, *HOG, *QN, *QR, *GA, *GB;
    float *G, *NG;
    bf16_t *CKp, *CVp, *CKs, *CVs, *SKp, *SVp, *WKp, *WVp, *SKs, *SVs, *WKs, *WVs, *MKVp;
    float *CCp, *CCs;
    bf16_t *KCp, *VCp, *KCs, *VCs;
    float *Lloc, *Dec; bf16_t* Sst;
    bf16_t *OHG, *OWIN, *OCMP, *MERGED;
    unsigned* SEL;
    float *Z1, *Z2; bf16_t *Z1b, *Z2b, *QM, *OM, *Hb;
};
__device__ __forceinline__ int ilv64(int c) { return (c & ~63) | (((c & 63) >> 1) + 32 * (c & 1)); }
__device__ __forceinline__ int win_src_col(int n) {
    const int tn = n >> 8, cl = n & 255;
    if (tn < 16) return n;
    if (tn < 20) return 4096 + (tn - 16) * 256 + ilv64(cl);
    if (tn < 26) { const int base = 5120 + (tn - 20) * 256; return base + ((tn == 22 || tn == 24) ? ilv64(cl) : cl); }
    if (tn == 26) return cl < 48 ? 6656 + cl : -1;
    if (tn < 31) return 6704 + (tn - 27) * 256 + cl;
    return 7728 + (tn - 31) * 256 + cl;
}

__device__ __forceinline__ void transpose_tile(const Params& p, int id, int nt, int kt, LAS float* tile  ) {
    const float* src; bf16_t* dst; int K, ldsrc; const float* gain = nullptr; const float* bias = nullptr; float* cs = nullptr; float* bw = nullptr; int map = 0;
    switch (id) {
        case 0: src = p.w_in; dst = p.Wt_in; K = 1024; ldsrc = NIN; map = 1; break;
        case 1: src = p.w_out; dst = p.Wt_out; K = 1024; ldsrc = 1024; break;
        case 2: src = p.w_mq; dst = p.Wt_mq; K = 1024; ldsrc = 1024; gain = p.ln_g; bias = p.ln_b; cs = p.cs_mq; bw = p.bw_mq; break;
        case 3: src = p.w_mkv; dst = p.Wt_mkv; K = 1024; ldsrc = 2048; break;
        case 4: src = p.w_mo; dst = p.Wt_mo; K = 1024; ldsrc = 1024; break;
        case 5: src = p.w_up; dst = p.Wt_up; K = 1024; ldsrc = 4096; gain = p.ln_g + 1024; bias = p.ln_b + 1024; cs = p.cs_up; bw = p.bw_up; break;
        case 6: src = p.w_down; dst = p.Wt_down; K = 4096; ldsrc = 1024; break;
        case 7: case 8: case 9: case 10: { const int sel = (id - 7) >> 1, half = (id - 7) & 1; src = p.cmp_w1 + (size_t)(sel * 2048 + half * 1024) * 128; dst = p.W1t + (size_t)(sel * 256 + half * 128) * 1024; K = 1024; ldsrc = 128; break; }
        default: { const int sel = id - 11; src = p.cmp_w2 + (size_t)sel * 128 * 64; dst = p.W2t + (size_t)sel * 64 * 128; K = 128; ldsrc = 64; map = (sel == 0) ? 2 : 0; break; }
    }
    const int t = threadIdx.x, n0 = nt * 64, k0 = kt * 64;
    {
        const int nn = t & 63; int sc = n0 + nn;
        if (map == 1) sc = win_src_col(sc); else if (map == 2) sc = ilv64(sc);
#pragma unroll
        for (int rr = 0; rr < 8; ++rr) {
            const int kk = (t >> 6) + 8 * rr;
            float v = (sc >= 0) ? src[(size_t)(k0 + kk) * ldsrc + sc] : 0.f;
            tile[kk * 65 + nn] = v;
        }
    }
    __syncthreads();
    {
        const int nn = t >> 3, kc = (t & 7) * 8;
        float w[8];
#pragma unroll
        for (int j = 0; j < 8; ++j) { float v = tile[(kc + j) * 65 + nn]; if (gain) v *= gain[k0 + kc + j]; w[j] = v; }
        u32x4 o; o.x = cvt_pk_bf16(w[0], w[1]); o.y = cvt_pk_bf16(w[2], w[3]); o.z = cvt_pk_bf16(w[4], w[5]); o.w = cvt_pk_bf16(w[6], w[7]);
        *(u32x4*)(dst + (size_t)(n0 + nn) * K + k0 + kc) = o;
        if (cs) {
            float s1 = lo_bf(o.x) + hi_bf(o.x) + lo_bf(o.y) + hi_bf(o.y) + lo_bf(o.z) + hi_bf(o.z) + lo_bf(o.w) + hi_bf(o.w);
            float s2 = 0.f;
#pragma unroll
            for (int j = 0; j < 8; ++j) s2 += bias[k0 + kc + j] * tile[(kc + j) * 65 + nn];
            s1 += __shfl_xor(s1, 1); s1 += __shfl_xor(s1, 2); s1 += __shfl_xor(s1, 4);
            s2 += __shfl_xor(s2, 1); s2 += __shfl_xor(s2, 2); s2 += __shfl_xor(s2, 4);
            if ((t & 7) == 0) { atomicAdd(cs + n0 + nn, s1); atomicAdd(bw + n0 + nn, s2); }
        }
    }
    __syncthreads();
}

__device__ __forceinline__ void phase_prologue(const Params& p, LAS unsigned char* lds) {
    LAS float* tile = (LAS float*)lds;
    const int t = threadIdx.x, G = gridDim.x, wg = blockIdx.x;
    constexpr int NJ0 = 140 * 16, NJ1 = 256, NJ2 = 256, NJ3 = 512, NJ4 = 256, NJ5 = 1024, NJ6 = 1024, NJ7 = 32, NJ11 = 2;
    constexpr int TOT = NJ0 + NJ1 + NJ2 + NJ3 + NJ4 + NJ5 + NJ6 + 4 * NJ7 + 2 * NJ11;
    for (int j = wg; j < TOT; j += G) {
        int id, r = j, nkt;
        if (r < NJ0) { id = 0; nkt = 16; }
        else if ((r -= NJ0) < NJ1) { id = 1; nkt = 16; }
        else if ((r -= NJ1) < NJ2) { id = 2; nkt = 16; }
        else if ((r -= NJ2) < NJ3) { id = 3; nkt = 16; }
        else if ((r -= NJ3) < NJ4) { id = 4; nkt = 16; }
        else if ((r -= NJ4) < NJ5) { id = 5; nkt = 16; }
        else if ((r -= NJ5) < NJ6) { id = 6; nkt = 64; }
        else if ((r -= NJ6) < 4 * NJ7) { id = 7 + r / NJ7; r %= NJ7; nkt = 16; }
        else { r -= 4 * NJ7; id = 11 + r / NJ11; r %= NJ11; nkt = 2; }
        transpose_tile(p, id, r / nkt, r % nkt, tile);
    }
    {
        const size_t nx = (size_t)MT * DM / 8, nm = (size_t)NBATCH * MEMT * DM / 8;
        for (size_t i = (size_t)wg * 512 + t; i < nx + nm; i += (size_t)G * 512) {
            const float* s; bf16_t* d;
            if (i < nx) { const size_t e = i * 8; s = (e < (size_t)MP * DM) ? p.x_prompt + e : p.x_sample + (e - (size_t)MP * DM); d = p.Xb + e; }
            else { const size_t e = (i - nx) * 8; s = p.mem_prompt + e; d = p.Memb + e; }
            const f32x4 a = *(const f32x4*)s, b = *(const f32x4*)(s + 4);
            u32x4 o; o.x = cvt_pk_bf16(a[0], a[1]); o.y = cvt_pk_bf16(a[2], a[3]); o.z = cvt_pk_bf16(b[0], b[1]); o.w = cvt_pk_bf16(b[2], b[3]);
            *(u32x4*)d = o;
        }
    }
    {
        const size_t n = (size_t)DBATCH * PAST * 64;
        for (size_t i = (size_t)wg * 512 + t; i < n; i += (size_t)G * 512) {
            const int c = (int)(i & 63); const size_t bt = i >> 6; const int tt = (int)(bt & (PAST - 1)), b = (int)(bt >> 11);
            const int page = p.page_table[b * NPAGES + (tt >> 7)];
            const float* s = p.cache_cmp + ((size_t)page * PAGE + (tt & (PAGE - 1))) * 512 + c * 8;
            const int sel = c >> 5, kv = (c >> 3) & 3, d0 = (c & 7) * 8;
            bf16_t* d = (sel ? p.CVs : p.CKs) + (((size_t)kv * DBATCH + b) * PAST + tt) * 64 + d0;
            *(u32x4*)d = pack8(*(const f32x4*)s, *(const f32x4*)(s + 4));
        }
    }
    for (int i = wg * 512 + t; i < SEQ * 32; i += G * 512) {
        const int pos = i >> 5, fi = i & 31;
        const float inv = powf(10000.0f, -(float)fi / 32.0f);
        const float ang = (float)pos * inv;
        double rev = (double)ang * 0.15915494309189535; rev -= floor(rev);
        const float fr = (float)rev;
        p.rope[2 * i] = __builtin_amdgcn_cosf(fr); p.rope[2 * i + 1] = __builtin_amdgcn_sinf(fr);
    }
    for (int i = wg * 512 + t; i < 1024; i += G * 512) {
        const float a = p.hg_lb[i], b = p.hg_lb[1024 + i], m = fmaxf(a, b), ea = expf(a - m), eb = expf(b - m);
        p.lbv[i] = ea / (ea + eb);
    }
    for (int j = wg; j < 64; j += G) {
        const int sel = j >> 5, l = j & 31, h = t & 127, part = t >> 7;
        float s = 0.f;
        for (int d = part * 16; d < part * 16 + 16; ++d) s += p.cmp_pe[(sel * 32 + l) * 64 + d] * p.cmp_w1[((size_t)(sel * 32 + l) * 64 + d) * 128 + h];
        atomicAdd(p.posb + sel * 128 + h, s);
    }
}
#define EPI_FOR_FRAGS(...) \
    _Pragma("unroll") for (int ai = 0; ai < 2; ++ai) _Pragma("unroll") for (int m = 0; m < 4; ++m) _Pragma("unroll") for (int bj = 0; bj < 2; ++bj) { \
        const int row = u.pm * 256 + ai * 128 + wr * 64 + m * 16 + fr, cl = bj * 128 + wc * 32 + 8 * fq; \
        const f32x4 v0 = acc[ai][bj][m][0], v1 = acc[ai][bj][m][1]; (void)row; (void)cl; __VA_ARGS__ }


struct Epi1 {
    static constexpr bool PERM = true, AFTER_DRAIN = false;
    const Params* pp;
    __device__ __forceinline__ void operator()(const f32x4 (&acc)[2][2][4][2], const pg8::Unit& u, int wr, int wc, int fr, int fq) const {
        const Params& p = *pp;
        const int pn = u.pn;
        if (pn < 4 || (pn >= 12 && pn < 16)) {
            bf16_t* dst = (pn < 4) ? p.HQ + pn * 256 : p.HOG + (pn - 12) * 256;
            EPI_FOR_FRAGS({ f32x4 a, b; for (int j = 0; j < 4; ++j) { a[j] = siluf_(v0[j]); b[j] = siluf_(v1[j]); } *(u32x4*)(dst + (size_t)row * 1024 + cl) = pack8(a, b); })
        } else if (pn < 8) {
            const int c0 = (pn - 4) * 256;
            EPI_FOR_FRAGS({ const f32x4 l0 = *(const f32x4*)(p.lbv + c0 + cl), l1 = *(const f32x4*)(p.lbv + c0 + cl + 4); f32x4 a, b;
                for (int j = 0; j < 4; ++j) { a[j] = __logf(l0[j] + (1.f - l0[j]) * sigmoidf_(v0[j])); b[j] = __logf(l1[j] + (1.f - l1[j]) * sigmoidf_(v1[j])); }
                float* d = p.G + (size_t)row * 1024 + c0 + cl; *(f32x4*)d = a; *(f32x4*)(d + 4) = b; })
        } else if (pn < 12) {
            bf16_t* dst = p.HV + (pn - 8) * 256;
            EPI_FOR_FRAGS({ *(u32x4*)(dst + (size_t)row * 1024 + cl) = pack8(v0, v1); })
        } else if (pn < 20) {
            const int c0 = (pn - 16) * 256;
            EPI_FOR_FRAGS({ const int pos = row < MP ? (row & (SEQ - 1)) : PAST + ((row - MP) & 7);
                const f32x4 r0 = *(const f32x4*)(p.rope + ((size_t)pos * 32 + ((cl & 63) >> 1)) * 2), r1 = *(const f32x4*)(p.rope + ((size_t)pos * 32 + ((cl & 63) >> 1)) * 2 + 4);
                *(u32x4*)(p.QN + (size_t)row * 1024 + c0 + cl) = pack8(v0, v1);
                f32x4 a, b;
                a[0] = v0[0] * r0[0] - v0[1] * r0[1]; a[1] = v0[1] * r0[0] + v0[0] * r0[1]; a[2] = v0[2] * r0[2] - v0[3] * r0[3]; a[3] = v0[3] * r0[2] + v0[2] * r0[3];
                b[0] = v1[0] * r1[0] - v1[1] * r1[1]; b[1] = v1[1] * r1[0] + v1[0] * r1[1]; b[2] = v1[2] * r1[2] - v1[3] * r1[3]; b[3] = v1[3] * r1[2] + v1[2] * r1[3];
                *(u32x4*)(p.QR + (size_t)row * 1024 + c0 + cl) = pack8(a, b); })
        } else if (pn < 26) {
            const int br = (pn - 20) >> 1, sel = (pn - 20) & 1;
            EPI_FOR_FRAGS({
                const bool isp = row < MP; const int rs = row - MP, b = isp ? (row >> 13) : (rs >> 3), tt = isp ? (row & (SEQ - 1)) : (rs & 7);
                const int kv = cl >> 6, c6 = cl & 63;
                float* o = nullptr;
                if (br == 0) o = isp ? p.out + OFF_PCMP + (size_t)row * 512 : p.out + OFF_SCMP + (size_t)rs * 512;
                else if (br == 1) o = isp ? p.out + OFF_PSLC + (size_t)row * 512 : p.out + OFF_SSLC + (size_t)rs * 512;
                else { if (isp) { if (tt >= SEQ - WIN) o = p.out + OFF_PWIN + (size_t)(b * WIN + tt - (SEQ - WIN)) * 512; } else o = p.out + OFF_SWIN + (size_t)(b * WIN + (WIN - DSEQ) + tt) * 512; }
                bf16_t* cp;
                if (br == 0) cp = isp ? (sel ? p.CVp : p.CKp) + ((size_t)kv * MP + row) * 64 : nullptr;
                else if (br == 1) cp = isp ? (sel ? p.SVp : p.SKp) + ((size_t)kv * MP + row) * 64 : (sel ? p.SVs : p.SKs) + ((size_t)kv * MS + rs) * 64;
                else cp = isp ? (sel ? p.WVp : p.WKp) + ((size_t)kv * MP + row) * 64 : (sel ? p.WVs : p.WKs) + ((size_t)kv * MS + rs) * 64;
                if (sel == 1 || br == 0) {
                    if (o) { float* d = o + sel * 256 + cl; *(f32x4*)d = v0; *(f32x4*)(d + 4) = v1; }
                    if (cp) *(u32x4*)(cp + c6) = pack8(v0, v1);
                } else {
                    const int pos = isp ? tt : PAST + tt, i0 = c6 >> 1;
                    const f32x4 r0 = *(const f32x4*)(p.rope + ((size_t)pos * 32 + i0) * 2), r1 = *(const f32x4*)(p.rope + ((size_t)pos * 32 + i0) * 2 + 4);
                    f32x4 lo, hi;
                    lo[0] = v0[0] * r0[0] - v0[1] * r0[1]; hi[0] = v0[1] * r0[0] + v0[0] * r0[1]; lo[1] = v0[2] * r0[2] - v0[3] * r0[3]; hi[1] = v0[3] * r0[2] + v0[2] * r0[3];
                    lo[2] = v1[0] * r1[0] - v1[1] * r1[1]; hi[2] = v1[1] * r1[0] + v1[0] * r1[1]; lo[3] = v1[2] * r1[2] - v1[3] * r1[3]; hi[3] = v1[3] * r1[2] + v1[2] * r1[3];
                    if (o) { float* d = o + kv * 64 + i0; *(f32x4*)d = lo; *(f32x4*)(d + 32) = hi; }
                    if (cp) { u32x4 w; w.x = cvt_pk_bf16(lo[0], hi[0]); w.y = cvt_pk_bf16(lo[1], hi[1]); w.z = cvt_pk_bf16(lo[2], hi[2]); w.w = cvt_pk_bf16(lo[3], hi[3]); *(u32x4*)(cp + c6) = w; }
                } })
        } else if (pn == 26) {
            EPI_FOR_FRAGS({ if (cl < 48) { f32x4 a, b; for (int j = 0; j < 4; ++j) { a[j] = sigmoidf_(v0[j]); b[j] = sigmoidf_(v1[j]); } float* d = p.NG + (size_t)row * 48 + cl; *(f32x4*)d = a; *(f32x4*)(d + 4) = b; } })
        } else {
            bf16_t* dst = (pn < 31) ? p.GA + (pn - 27) * 256 : p.GB + (pn - 31) * 256;
            EPI_FOR_FRAGS({ f32x4 a, b; for (int j = 0; j < 4; ++j) { a[j] = sigmoidf_(v0[j]); b[j] = sigmoidf_(v1[j]); } *(u32x4*)(dst + (size_t)row * 1024 + cl) = pack8(a, b); })
        }
    }
};

struct EpiPlain {
    static constexpr bool PERM = true, AFTER_DRAIN = false;
    float* C; int ldc; bf16_t* Cb; int ldb;
    __device__ __forceinline__ void operator()(const f32x4 (&acc)[2][2][4][2], const pg8::Unit& u, int wr, int wc, int fr, int fq) const {
        EPI_FOR_FRAGS({ const int col = u.pn * 256 + cl;
            if (C) { float* d = C + (size_t)row * ldc + col; *(f32x4*)d = v0; *(f32x4*)(d + 4) = v1; }
            if (Cb) *(u32x4*)(Cb + (size_t)row * ldb + col) = pack8(v0, v1); })
    }
};

__device__ __forceinline__ void phase_gemm1(const Params& p, LAS unsigned char* lds) {
    pg8::Gemm g{p.Xb, p.Wt_in, MT, NINP, DM, DM};
    pg8::StaticOrder S; S.init(MT, NINP, gridDim.x, blockIdx.x);
    Epi1 E{&p};
    pg8::gemm_phase<Epi1, pg8::StaticOrder, false>(lds, g, S, E, nullptr);
}
template <int HD> __device__ __forceinline__ int ktile_byte(int key, int d) { const int st = (key >> 4) * (HD / 32) + (d >> 5), ob = (key & 15) * 64 + (d & 31) * 2; return st * 1024 + (ob ^ (((ob >> 9) & 1) << 5)); }
template <int HD> constexpr int vstride() { return HD * 2 + 32; }
template <int HD> constexpr int ktile_bytes() { return 64 * HD * 2; }
template <int HD> constexpr int vtile_bytes() { return 64 * vstride<HD>(); }
typedef short s16x4 __attribute__((ext_vector_type(4)));
constexpr float NEG_INF = -__builtin_huge_valf();

template <int HD> struct AttnTile {
    bf16x8 q[HD / 32];
    f32x4 o[HD / 16];
    float m, l;
    __device__ __forceinline__ void init() { m = NEG_INF; l = 0.f;
#pragma unroll
        for (int i = 0; i < HD / 16; ++i) o[i] = (f32x4){0.f, 0.f, 0.f, 0.f}; }
};

template <int HD, int NT> __device__ __forceinline__ void attn_scores(f32x4 (&s)[NT][4], const AttnTile<HD> (&T)[NT], const bool (&act)[NT], const LAS unsigned char* Kt, int lane) {
    const int fr = lane & 15, g = lane >> 4;
#pragma unroll
    for (int u = 0; u < NT; ++u)
#pragma unroll
        for (int kt = 0; kt < 4; ++kt) s[u][kt] = (f32x4){0.f, 0.f, 0.f, 0.f};
#pragma unroll
    for (int kt = 0; kt < 4; ++kt)
#pragma unroll
        for (int ds = 0; ds < HD / 32; ++ds) {
            const bf16x8 kf = *(const LAS bf16x8*)(Kt + ktile_byte<HD>(16 * kt + fr, 32 * ds + 8 * g));
#pragma unroll
            for (int u = 0; u < NT; ++u) if (act[u]) s[u][kt] = __builtin_amdgcn_mfma_f32_16x16x32_bf16(kf, T[u].q[ds], s[u][kt], 0, 0, 0);
        }
}
template <int HD, int NT> __device__ __forceinline__ void attn_pv(AttnTile<HD> (&T)[NT], const bool (&act)[NT], const bf16x8 (&pf)[NT][2], const LAS unsigned char* Vt, int lane) {
    const int fr = lane & 15, g = lane >> 4;
    const LAS unsigned char* vb = Vt + (4 * g + (fr >> 2)) * vstride<HD>() + (fr & 3) * 8;
#pragma unroll
    for (int dt = 0; dt < HD / 16; ++dt)
#pragma unroll
        for (int ph = 0; ph < 2; ++ph) {
            const s16x4 a = __builtin_amdgcn_ds_read_tr16_b64_v4i16((LAS s16x4*)(vb + (32 * ph) * vstride<HD>() + dt * 32));
            const s16x4 b = __builtin_amdgcn_ds_read_tr16_b64_v4i16((LAS s16x4*)(vb + (32 * ph + 16) * vstride<HD>() + dt * 32));
            const bf16x8 vf = {a[0], a[1], a[2], a[3], b[0], b[1], b[2], b[3]};
#pragma unroll
            for (int u = 0; u < NT; ++u) if (act[u]) T[u].o[dt] = __builtin_amdgcn_mfma_f32_16x16x32_bf16(vf, pf[u][ph], T[u].o[dt], 0, 0, 0);
        }
}
__device__ __forceinline__ float xmax16_32(float v) { v = fmaxf(v, __shfl_xor(v, 16)); return fmaxf(v, __shfl_xor(v, 32)); }
__device__ __forceinline__ float xsum16_32(float v) { v += __shfl_xor(v, 16); return v + __shfl_xor(v, 32); }

template <int HD, int NT, class MaskF>
__device__ __forceinline__ void attn_block(AttnTile<HD> (&T)[NT], const bool (&act)[NT], const LAS unsigned char* Kt, const LAS unsigned char* Vt, float c, bool use_mask, MaskF&& mask, int lane) {
    const int g = lane >> 4;
    f32x4 s[NT][4];
    attn_scores<HD, NT>(s, T, act, Kt, lane);
    bf16x8 pf[NT][2];
#pragma unroll
    for (int u = 0; u < NT; ++u) {
        if (!act[u]) { pf[u][0] = (bf16x8){0, 0, 0, 0, 0, 0, 0, 0}; pf[u][1] = pf[u][0]; continue; }
        if (use_mask) {
#pragma unroll
            for (int kt = 0; kt < 4; ++kt)
#pragma unroll
                for (int r = 0; r < 4; ++r) if (!mask(u, 16 * kt + 4 * g + r)) s[u][kt][r] = NEG_INF;
        }
        float mx = NEG_INF;
#pragma unroll
        for (int kt = 0; kt < 4; ++kt) mx = fmaxf(mx, fmaxf(fmaxf(s[u][kt][0], s[u][kt][1]), fmaxf(s[u][kt][2], s[u][kt][3])));
        mx = xmax16_32(mx);
        const float mnew = fmaxf(T[u].m, mx), msafe = (mnew == NEG_INF) ? 0.f : mnew;
        const float alpha = __builtin_amdgcn_exp2f((T[u].m - msafe) * c), mc = msafe * c;
        float ps = 0.f;
#pragma unroll
        for (int kt = 0; kt < 4; ++kt)
#pragma unroll
            for (int r = 0; r < 4; ++r) { const float e = __builtin_amdgcn_exp2f(s[u][kt][r] * c - mc); s[u][kt][r] = e; ps += e; }
        T[u].l = T[u].l * alpha + ps; T[u].m = mnew;
#pragma unroll
        for (int dt = 0; dt < HD / 16; ++dt) T[u].o[dt] *= alpha;
#pragma unroll
        for (int ph = 0; ph < 2; ++ph) {
            u32x4 w; w.x = cvt_pk_bf16(s[u][2 * ph][0], s[u][2 * ph][1]); w.y = cvt_pk_bf16(s[u][2 * ph][2], s[u][2 * ph][3]);
            w.z = cvt_pk_bf16(s[u][2 * ph + 1][0], s[u][2 * ph + 1][1]); w.w = cvt_pk_bf16(s[u][2 * ph + 1][2], s[u][2 * ph + 1][3]);
            pf[u][ph] = __builtin_bit_cast(bf16x8, w);
        }
    }
    attn_pv<HD, NT>(T, act, pf, Vt, lane);
}

__device__ __forceinline__ void stage_k64_bf16(LAS unsigned char* Kt, const bf16_t* src, int nvalid) {
    const int t = threadIdx.x, key = t >> 3, ch = t & 7;
    u32x4 v = (u32x4){0u, 0u, 0u, 0u}; if (key < nvalid) v = *(const u32x4*)(src + (size_t)key * 64 + ch * 8);
    *(LAS u32x4*)(Kt + ktile_byte<64>(key, ch * 8)) = v;
}
__device__ __forceinline__ void stage_v64_bf16(LAS unsigned char* Vt, const bf16_t* src, int nvalid) {
    const int t = threadIdx.x, key = t >> 3, ch = t & 7;
    u32x4 v = (u32x4){0u, 0u, 0u, 0u}; if (key < nvalid) v = *(const u32x4*)(src + (size_t)key * 64 + ch * 8);
    *(LAS u32x4*)(Vt + key * vstride<64>() + ch * 16) = v;
}
__device__ __forceinline__ void stage_k64_f32(LAS unsigned char* Kt, const float* src, size_t row_stride, int nvalid, float* copy, size_t copy_stride, int copy_from) {
    const int t = threadIdx.x, key = t >> 3, ch = t & 7;
    u32x4 v = (u32x4){0u, 0u, 0u, 0u};
    if (key < nvalid) { const float* s = src + (size_t)key * row_stride + ch * 4; const f32x4 a = *(const f32x4*)s, b = *(const f32x4*)(s + 32);
        v.x = cvt_pk_bf16(a[0], b[0]); v.y = cvt_pk_bf16(a[1], b[1]); v.z = cvt_pk_bf16(a[2], b[2]); v.w = cvt_pk_bf16(a[3], b[3]);
        if (copy && key >= copy_from) { float* d = copy + (size_t)key * copy_stride + ch * 4; *(f32x4*)d = a; *(f32x4*)(d + 32) = b; } }
    *(LAS u32x4*)(Kt + ktile_byte<64>(key, ch * 8)) = v;
}
__device__ __forceinline__ void stage_v64_f32(LAS unsigned char* Vt, const float* src, size_t row_stride, int nvalid, float* copy, size_t copy_stride, int copy_from) {
    const int t = threadIdx.x, key = t >> 3, ch = t & 7;
    u32x4 v = (u32x4){0u, 0u, 0u, 0u};
    if (key < nvalid) { const float* s = src + (size_t)key * row_stride + ch * 8; const f32x4 a = *(const f32x4*)s, b = *(const f32x4*)(s + 4);
        v = pack8(a, b);
        if (copy && key >= copy_from) { float* d = copy + (size_t)key * copy_stride + ch * 8; *(f32x4*)d = a; *(f32x4*)(d + 4) = b; } }
    *(LAS u32x4*)(Vt + key * vstride<64>() + ch * 16) = v;
}

constexpr float ATT_C = 0.125f * 1.44269504088896f;
constexpr int L_KT = 1024, L_VT = L_KT + 4 * 8192, L_BQ = L_VT + 4 * 10240, L_BE = L_BQ + 32768, L_MISC = L_BE + 32768;

template <int HD> __device__ __forceinline__ void attn_store_bf16(const AttnTile<HD>& T, bf16_t* dst, int lane) {
    const int g = lane >> 4; const float inv = 1.0f / fmaxf(xsum16_32(T.l), 1e-30f);
#pragma unroll
    for (int dt = 0; dt < HD / 16; ++dt) { u32x2 w; w.x = cvt_pk_bf16(T.o[dt][0] * inv, T.o[dt][1] * inv); w.y = cvt_pk_bf16(T.o[dt][2] * inv, T.o[dt][3] * inv); *(u32x2*)(dst + 16 * dt + 4 * g) = w; }
}

__device__ __forceinline__ void win_unit_prompt(const Params& p, int unit, LAS unsigned char* lds) {
    const int b = unit >> 9, kv = (unit >> 7) & 3, qt = unit & 127, t0 = qt * 64;
    const int lane = threadIdx.x & 63, w = threadIdx.x >> 6, fr = lane & 15, g = lane >> 4;
    AttnTile<64> T[2]; const bool act[2] = {true, true};
#pragma unroll
    for (int u = 0; u < 2; ++u) { T[u].init(); const size_t row = (size_t)b * SEQ + t0 + 8 * w + 4 * u + (fr >> 2);
        const bf16_t* q = p.QR + row * 1024 + (kv * 4 + (fr & 3)) * 64 + 8 * g; T[u].q[0] = *(const bf16x8*)q; T[u].q[1] = *(const bf16x8*)(q + 32); }
    LAS unsigned char* Kt = lds + L_KT; LAS unsigned char* Vt = lds + L_VT;
    const int kb0 = qt >= 8 ? qt - 8 : 0;
    for (int kb = kb0; kb <= qt; ++kb) {
        __syncthreads();
        stage_k64_bf16(Kt, p.WKp + ((size_t)kv * MP + (size_t)b * SEQ + kb * 64) * 64, 64);
        stage_v64_bf16(Vt, p.WVp + ((size_t)kv * MP + (size_t)b * SEQ + kb * 64) * 64, 64);
        __syncthreads();
        const int kbase = kb * 64;
        attn_block<64, 2>(T, act, Kt, Vt, ATT_C, kb == qt || kb == qt - 8, [&](int u, int kl) { const int qpos = t0 + 8 * w + 4 * u + (fr >> 2), kpos = kbase + kl; return kpos <= qpos && kpos > qpos - WIN; }, lane);
    }
#pragma unroll
    for (int u = 0; u < 2; ++u) { const int qpos = t0 + 8 * w + 4 * u + (fr >> 2);
        if (qpos < WIN - 1) { const float mnew = fmaxf(T[u].m, 0.f), alpha = __builtin_amdgcn_exp2f((T[u].m - mnew) * ATT_C);
            T[u].l = T[u].l * alpha + (g == 0 ? (float)(WIN - 1 - qpos) * __builtin_amdgcn_exp2f(-mnew * ATT_C) : 0.f); T[u].m = mnew;
#pragma unroll
            for (int dt = 0; dt < 4; ++dt) T[u].o[dt] *= alpha; } }
#pragma unroll
    for (int u = 0; u < 2; ++u) { const size_t row = (size_t)b * SEQ + t0 + 8 * w + 4 * u + (fr >> 2); attn_store_bf16<64>(T[u], p.OWIN + row * 1024 + (kv * 4 + (fr & 3)) * 64, lane); }
}
__device__ __forceinline__ void win_unit_sample(const Params& p, int unit, LAS unsigned char* lds) {
    const int b = unit >> 2, kv = unit & 3;
    const int lane = threadIdx.x & 63, w = threadIdx.x >> 6, fr = lane & 15, g = lane >> 4;
    AttnTile<64> T[2]; const bool act[2] = {w == 0, w == 0};
#pragma unroll
    for (int u = 0; u < 2; ++u) { T[u].init(); const size_t row = (size_t)MP + b * 8 + 4 * u + (fr >> 2);
        const bf16_t* q = p.QR + row * 1024 + (kv * 4 + (fr & 3)) * 64 + 8 * g; T[u].q[0] = *(const bf16x8*)q; T[u].q[1] = *(const bf16x8*)(q + 32); }
    LAS unsigned char* Kt = lds + L_KT; LAS unsigned char* Vt = lds + L_VT;
    for (int kb = 0; kb < 9; ++kb) {
        __syncthreads();
        if (kb < 8) {
            const float* src = p.cache_win + ((size_t)b * WIN + kb * 64) * 512 + kv * 64;
            float* cp = p.out + OFF_SWIN + ((size_t)b * WIN + kb * 64 - DSEQ) * 512 + kv * 64;
            stage_k64_f32(Kt, src, 512, 64, cp, 512, kb == 0 ? DSEQ : 0);
            stage_v64_f32(Vt, src + 256, 512, 64, cp + 256, 512, kb == 0 ? DSEQ : 0);
        } else {
            stage_k64_bf16(Kt, p.WKs + ((size_t)kv * MS + b * 8) * 64, 8);
            stage_v64_bf16(Vt, p.WVs + ((size_t)kv * MS + b * 8) * 64, 8);
        }
        __syncthreads();
        if (w == 0) attn_block<64, 2>(T, act, Kt, Vt, ATT_C, kb == 0 || kb == 8, [&](int u, int kl) { const int tok = 4 * u + (fr >> 2); return kb == 0 ? (kl > tok) : (kl <= tok); }, lane);
    }
    if (w == 0) {
#pragma unroll
        for (int u = 0; u < 2; ++u) { const size_t row = (size_t)MP + b * 8 + 4 * u + (fr >> 2); attn_store_bf16<64>(T[u], p.OWIN + row * 1024 + (kv * 4 + (fr & 3)) * 64, lane); }
    }
}
__device__ __forceinline__ unsigned fkey(float f) { const unsigned b = __float_as_uint(f); return b ^ ((b >> 31) ? 0xffffffffu : 0x80000000u); }
__device__ __forceinline__ int gsum8(int v) { v += __shfl_xor(v, 1); v += __shfl_xor(v, 2); v += __shfl_xor(v, 4); return v; }

__device__ __forceinline__ void cmp_unit(const Params& p, bool sample, int unit, LAS unsigned char* lds) {
    const int lane = threadIdx.x & 63, w = threadIdx.x >> 6, fr = lane & 15, g = lane >> 4;
    int b, kv, qt, t0, nkeys_tot; size_t row0; const bf16_t *KC, *VC;
    if (!sample) { b = unit >> 9; kv = (unit >> 7) & 3; qt = unit & 127; t0 = qt * 64; row0 = (size_t)b * SEQ + t0; nkeys_tot = NCMP_P;
        KC = p.KCp + (size_t)(b * 4 + kv) * 512 * 64; VC = p.VCp + (size_t)(b * 4 + kv) * 512 * 64; }
    else { b = unit >> 2; kv = unit & 3; qt = PAST / 64; t0 = PAST; row0 = (size_t)MP + b * 8; nkeys_tot = NCMP_S;
        KC = p.KCs + (size_t)(b * 4 + kv) * 128 * 64; VC = p.VCs + (size_t)(b * 4 + kv) * 128 * 64; }
    const bool wact = !sample || w == 0;
    const int tmax = sample ? PAST + 7 : t0 + 63;
    int nv = tmax >= 31 ? (tmax - 31) / 16 + 1 : 0; if (nv > nkeys_tot) nv = nkeys_tot;
    const int nblk = (nv + 63) >> 6;
    AttnTile<64> T[2]; const bool act[2] = {wact, wact};
    int qpos[2];
#pragma unroll
    for (int u = 0; u < 2; ++u) { T[u].init(); const int tl = 8 * w + 4 * u + (fr >> 2); qpos[u] = t0 + (sample ? (tl & 7) : tl); const size_t row = row0 + (sample ? (tl & 7) : tl);
        const bf16_t* q = p.QN + row * 1024 + (kv * 4 + (fr & 3)) * 64 + 8 * g; T[u].q[0] = *(const bf16x8*)q; T[u].q[1] = *(const bf16x8*)(q + 32); }
    LAS unsigned char* Kt = lds + L_KT; LAS unsigned char* Vt = lds + L_VT;
    LAS float* BQ = (LAS float*)(lds + L_BQ); LAS float* BE = (LAS float*)(lds + L_BE);
    __syncthreads();
    for (int i = threadIdx.x; i < 64 * 128; i += 512) { BQ[i] = 0.f; BE[i] = 0.f; }
    for (int kb = 0; kb < nblk; ++kb) {
        __syncthreads();
        stage_k64_bf16(Kt, KC + (size_t)kb * 64 * 64, nv - kb * 64);
        __syncthreads();
        if (wact) {
            f32x4 s[2][4]; attn_scores<64, 2>(s, T, act, Kt, lane);
#pragma unroll
            for (int u = 0; u < 2; ++u) {
                float mx = NEG_INF;
#pragma unroll
                for (int kt = 0; kt < 4; ++kt)
#pragma unroll
                    for (int r = 0; r < 4; ++r) { const int n = kb * 64 + 16 * kt + 4 * g + r; if (16 * n + 31 > qpos[u] || n >= nv) s[u][kt][r] = NEG_INF; mx = fmaxf(mx, s[u][kt][r]); }
                mx = xmax16_32(mx);
                const float mnew = fmaxf(T[u].m, mx), msafe = (mnew == NEG_INF) ? 0.f : mnew, alpha = __builtin_amdgcn_exp2f((T[u].m - msafe) * ATT_C), mc = msafe * ATT_C;
                float ps = 0.f;
#pragma unroll
                for (int kt = 0; kt < 4; ++kt)
#pragma unroll
                    for (int r = 0; r < 4; ++r) ps += __builtin_amdgcn_exp2f(s[u][kt][r] * ATT_C - mc);
                T[u].l = T[u].l * alpha + ps; T[u].m = mnew;
            }
        }
    }
    float mfin[2], linv[2];
#pragma unroll
    for (int u = 0; u < 2; ++u) { const float lt = xsum16_32(T[u].l); linv[u] = 1.0f / fmaxf(lt, 1e-30f); mfin[u] = ((T[u].m == NEG_INF) ? 0.f : T[u].m) * ATT_C; }
    for (int kb = 0; kb < nblk; ++kb) {
        __syncthreads();
        stage_k64_bf16(Kt, KC + (size_t)kb * 64 * 64, nv - kb * 64);
        stage_v64_bf16(Vt, VC + (size_t)kb * 64 * 64, nv - kb * 64);
        __syncthreads();
        if (wact) {
            f32x4 s[2][4]; attn_scores<64, 2>(s, T, act, Kt, lane);
            bf16x8 pf[2][2];
#pragma unroll
            for (int u = 0; u < 2; ++u) {
#pragma unroll
                for (int kt = 0; kt < 4; ++kt) {
                    float qs = 0.f;
#pragma unroll
                    for (int r = 0; r < 4; ++r) { const int n = kb * 64 + 16 * kt + 4 * g + r; const bool ok = (16 * n + 31 <= qpos[u]) && n < nv;
                        const float e = ok ? __builtin_amdgcn_exp2f(s[u][kt][r] * ATT_C - mfin[u]) * linv[u] : 0.f; s[u][kt][r] = e; qs += e; }
                    float es = s[u][kt][3];
                    qs += __shfl_xor(qs, 1); qs += __shfl_xor(qs, 2); es += __shfl_xor(es, 1); es += __shfl_xor(es, 2);
                    if ((fr & 3) == 0) { const int tl = (sample ? 0 : 8 * w) + 4 * u + (fr >> 2), jq = kb * 16 + 4 * kt + g; BQ[tl * 128 + jq] = qs; BE[tl * 128 + jq] = es; }
                }
#pragma unroll
                for (int ph = 0; ph < 2; ++ph) {
                    u32x4 wv; wv.x = cvt_pk_bf16(s[u][2 * ph][0], s[u][2 * ph][1]); wv.y = cvt_pk_bf16(s[u][2 * ph][2], s[u][2 * ph][3]);
                    wv.z = cvt_pk_bf16(s[u][2 * ph + 1][0], s[u][2 * ph + 1][1]); wv.w = cvt_pk_bf16(s[u][2 * ph + 1][2], s[u][2 * ph + 1][3]);
                    pf[u][ph] = __builtin_bit_cast(bf16x8, wv);
                }
            }
            attn_pv<64, 2>(T, act, pf, Vt, lane);
        }
    }
    if (wact) {
#pragma unroll
        for (int u = 0; u < 2; ++u) { const int tl = 8 * w + 4 * u + (fr >> 2); const size_t row = row0 + (sample ? (tl & 7) : tl); bf16_t* dst = p.OCMP + row * 1024 + (kv * 4 + (fr & 3)) * 64;
#pragma unroll
            for (int dt = 0; dt < 4; ++dt) { u32x2 wv; wv.x = cvt_pk_bf16(T[u].o[dt][0], T[u].o[dt][1]); wv.y = cvt_pk_bf16(T[u].o[dt][2], T[u].o[dt][3]); *(u32x2*)(dst + 16 * dt + 4 * g) = wv; } }
        asm volatile("s_waitcnt lgkmcnt(0)" ::: "memory");
        const int tk = lane >> 3, sub = lane & 7, tl = (sample ? 0 : 8 * w) + tk, cur = qt;
        unsigned key[16];
#pragma unroll
        for (int i = 0; i < 16; ++i) { const int j = 16 * sub + i; const float sc = BQ[tl * 128 + j] + (j > 0 ? BE[tl * 128 + j - 1] : 0.f);
            const bool forced = (j == 0) || (j == cur) || (j == cur - 1), valid = j <= cur;
            key[i] = fkey(forced ? 1e9f : (valid ? sc : -1.0f)); }
        unsigned thr = 0u;
        for (int bit = 31; bit >= 0; --bit) { const unsigned cand = thr | (1u << bit); int c = 0;
#pragma unroll
            for (int i = 0; i < 16; ++i) c += (key[i] >= cand) ? 1 : 0;
            c = gsum8(c); if (c >= 16) thr = cand; }
        unsigned gtm = 0u, eqm = 0u;
#pragma unroll
        for (int i = 0; i < 16; ++i) { gtm |= (key[i] > thr) ? (1u << i) : 0u; eqm |= (key[i] == thr) ? (1u << i) : 0u; }
        const int ngt = gsum8(__popc(gtm)), neq = __popc(eqm);
        int pre = neq;
        { int v = __shfl_up(pre, 1); if (sub >= 1) pre += v; v = __shfl_up(pre, 2); if (sub >= 2) pre += v; v = __shfl_up(pre, 4); if (sub >= 4) pre += v; }
        int take = (16 - ngt) - (pre - neq); take = take < 0 ? 0 : (take > neq ? neq : take);
        unsigned sel = gtm, em = eqm;
        for (int i = 0; i < take; ++i) { const unsigned low = em & (0u - em); sel |= low; em ^= low; }
        unsigned vm = 0u;
#pragma unroll
        for (int i = 0; i < 16; ++i) vm |= (16 * sub + i <= cur) ? (1u << i) : 0u;
        sel &= vm;
        const unsigned hi = __shfl_down(sel, 1);
        if ((sub & 1) == 0) p.SEL[(row0 + (sample ? tk : 8 * w + tk)) * 16 + kv * 4 + (sub >> 1)] = sel | (hi << 16);
    }
}

__device__ __forceinline__ void slc_unit(const Params& p, bool sample, int unit, LAS unsigned char* lds) {
    const int lane = threadIdx.x & 63, w = threadIdx.x >> 6, fr = lane & 15, g = lane >> 4;
    int b, kv, cur, t0; size_t row0;
    if (!sample) { b = unit >> 9; kv = (unit >> 7) & 3; cur = unit & 127; t0 = cur * 64; row0 = (size_t)b * SEQ + t0; }
    else { b = unit >> 2; kv = unit & 3; cur = PAST / 64; t0 = PAST; row0 = (size_t)MP + b * 8; }
    const bool wact = !sample || w == 0;
    AttnTile<64> T[2]; unsigned selw[2][4]; int qpos[2]; size_t rowu[2];
#pragma unroll
    for (int u = 0; u < 2; ++u) { T[u].init(); const int tl = 8 * w + 4 * u + (fr >> 2), tli = sample ? (tl & 7) : tl; qpos[u] = t0 + tli; rowu[u] = row0 + tli;
        const bf16_t* q = p.QR + rowu[u] * 1024 + (kv * 4 + (fr & 3)) * 64 + 8 * g; T[u].q[0] = *(const bf16x8*)q; T[u].q[1] = *(const bf16x8*)(q + 32);
        const u32x4 sw = *(const u32x4*)(p.SEL + rowu[u] * 16 + kv * 4); selw[u][0] = sw.x; selw[u][1] = sw.y; selw[u][2] = sw.z; selw[u][3] = sw.w; }
    LAS unsigned char* Kt = lds + L_KT; LAS unsigned char* Vt = lds + L_VT;
    for (int j0 = 0; j0 <= cur; j0 += 4) {
        __syncthreads();
#pragma unroll
        for (int jj = 0; jj < 4; ++jj) { const int j = j0 + jj; if (j > cur) break;
            if (!sample) { const size_t kr = ((size_t)kv * MP + (size_t)b * SEQ + (size_t)j * 64) * 64; stage_k64_bf16(Kt + jj * 8192, p.SKp + kr, 64); stage_v64_bf16(Vt + jj * 10240, p.SVp + kr, 64); }
            else if (j < PAST / 64) { const int page = p.page_table[b * NPAGES + (j >> 1)]; const float* src = p.cache_slc + ((size_t)page * PAGE + (j & 1) * 64) * 512 + kv * 64;
                stage_k64_f32(Kt + jj * 8192, src, 512, 64, nullptr, 0, 0); stage_v64_f32(Vt + jj * 10240, src + 256, 512, 64, nullptr, 0, 0); }
            else { stage_k64_bf16(Kt + jj * 8192, p.SKs + ((size_t)kv * MS + b * 8) * 64, 8); stage_v64_bf16(Vt + jj * 10240, p.SVs + ((size_t)kv * MS + b * 8) * 64, 8); }
        }
        __syncthreads();
        if (wact) {
#pragma unroll
            for (int jj = 0; jj < 4; ++jj) { const int j = j0 + jj; if (j > cur) break;
                bool mybit[2], act[2];
#pragma unroll
                for (int u = 0; u < 2; ++u) { const unsigned wd = (j >> 5) == 0 ? selw[u][0] : (j >> 5) == 1 ? selw[u][1] : (j >> 5) == 2 ? selw[u][2] : selw[u][3]; mybit[u] = (wd >> (j & 31)) & 1u; act[u] = __ballot(mybit[u]) != 0ull; }
                if (!act[0] && !act[1]) continue;
                const int kbase = j * 64;
                attn_block<64, 2>(T, act, Kt + jj * 8192, Vt + jj * 10240, ATT_C, true, [&](int u, int kl) { return mybit[u] && (kbase + kl <= qpos[u]); }, lane);
            }
        }
    }
    if (wact) {
#pragma unroll
        for (int u = 0; u < 2; ++u) {
            const int head = kv * 4 + (fr & 3); const size_t base = rowu[u] * 1024 + head * 64;
            const float inv = 1.0f / fmaxf(xsum16_32(T[u].l), 1e-30f);
            const float gc = p.NG[rowu[u] * 48 + head], gs = p.NG[rowu[u] * 48 + 16 + head], gw = p.NG[rowu[u] * 48 + 32 + head];
#pragma unroll
            for (int dt = 0; dt < 4; ++dt) { const size_t o = base + 16 * dt + 4 * g;
                const u32x2 ga = *(const u32x2*)(p.GA + o), gb = *(const u32x2*)(p.GB + o), hg = *(const u32x2*)(p.OHG + o), oc = *(const u32x2*)(p.OCMP + o), ow = *(const u32x2*)(p.OWIN + o);
                float r[4];
                r[0] = lo_bf(ga.x) * lo_bf(hg.x) + lo_bf(gb.x) * (gc * lo_bf(oc.x) + gs * T[u].o[dt][0] * inv + gw * lo_bf(ow.x));
                r[1] = hi_bf(ga.x) * hi_bf(hg.x) + hi_bf(gb.x) * (gc * hi_bf(oc.x) + gs * T[u].o[dt][1] * inv + gw * hi_bf(ow.x));
                r[2] = lo_bf(ga.y) * lo_bf(hg.y) + lo_bf(gb.y) * (gc * lo_bf(oc.y) + gs * T[u].o[dt][2] * inv + gw * lo_bf(ow.y));
                r[3] = hi_bf(ga.y) * hi_bf(hg.y) + hi_bf(gb.y) * (gc * hi_bf(oc.y) + gs * T[u].o[dt][3] * inv + gw * hi_bf(ow.y));
                u32x2 wv; wv.x = cvt_pk_bf16(r[0], r[1]); wv.y = cvt_pk_bf16(r[2], r[3]); *(u32x2*)(p.MERGED + o) = wv; }
        }
    }
}
struct CmpOrder {
    int G, c;
    __device__ bool next(int i, pg8::Unit& u) const { const int L = i * G + c; if (L >= 544) return false; u.pm = L; u.pn = (L >= 272) ? 1 : 0; return true; }
    __device__ __forceinline__ void a_ready(const pg8::Unit&) const {}
    __device__ __forceinline__ void done(const pg8::Unit&) const {}
};
struct EpiCmp {
    static constexpr bool PERM = true, AFTER_DRAIN = false;
    float* C;
    __device__ __forceinline__ void operator()(const f32x4 (&acc)[2][2][4][2], const pg8::Unit& u, int wr, int wc, int fr, int fq) const {
        EPI_FOR_FRAGS({ float* d = C + (size_t)row * 256 + cl; *(f32x4*)d = v0; *(f32x4*)(d + 4) = v1; })
    }
};
__device__ __forceinline__ float gelu_tanh(float x) { const float y = 0.7978845608028654f * (x + 0.044715f * x * x * x); const float e = fast_exp(2.0f * y); return x * (1.0f - __builtin_amdgcn_rcpf(1.0f + e)); }
__device__ __forceinline__ void cmp_stage2(const Params& p) {
    const int lane = threadIdx.x & 63, fr = lane & 15, g = lane >> 4;
    const int gw = blockIdx.x * 8 + (threadIdx.x >> 6), nw = gridDim.x * 8;
    constexpr int NT_P = 2 * 8 * 32, NT_S = 2 * 512 * 8;
    for (int tile = gw; tile < NT_P + NT_S; tile += nw) {
        int sel, grp, i0, ntok; size_t arow0; bf16_t* dst;
        if (tile < NT_P) { sel = tile >> 8; grp = (tile >> 5) & 7; i0 = (tile & 31) * 16; ntok = NCMP_P; const int kv = grp >> 1, b = grp & 1;
            arow0 = (size_t)sel * 69632 + grp * 512; dst = (sel ? p.VCp : p.KCp) + (size_t)(b * 4 + kv) * 512 * 64; }
        else { const int t2 = tile - NT_P; sel = t2 >> 12; grp = (t2 >> 3) & 511; i0 = (t2 & 7) * 16; ntok = NCMP_S; const int kv = grp >> 7, b = grp & 127;
            arow0 = (size_t)sel * 69632 + 4096 + (size_t)grp * 128; dst = (sel ? p.VCs : p.KCs) + (size_t)(b * 4 + kv) * 128 * 64; }
        const int i = i0 + fr; const bool ok = i < ntok; const int ic = ok ? i : ntok - 1;
        const float* c1 = p.CCp + (arow0 + ic) * 256; const float* c2 = p.CCp + (arow0 + ic + 1) * 256 + 128;
        f32x4 acc[4];
#pragma unroll
        for (int nt = 0; nt < 4; ++nt) acc[nt] = (f32x4){0.f, 0.f, 0.f, 0.f};
#pragma unroll
        for (int ks = 0; ks < 4; ++ks) {
            const int h = 32 * ks + 8 * g; float hv[8];
#pragma unroll
            for (int q4 = 0; q4 < 2; ++q4) { const f32x4 a = *(const f32x4*)(c1 + h + 4 * q4), b2 = *(const f32x4*)(c2 + h + 4 * q4), pb = *(const f32x4*)(p.posb + sel * 128 + h + 4 * q4);
#pragma unroll
                for (int j = 0; j < 4; ++j) hv[4 * q4 + j] = gelu_tanh(a[j] + b2[j] + pb[j]); }
            u32x4 w; w.x = cvt_pk_bf16(hv[0], hv[1]); w.y = cvt_pk_bf16(hv[2], hv[3]); w.z = cvt_pk_bf16(hv[4], hv[5]); w.w = cvt_pk_bf16(hv[6], hv[7]);
            const bf16x8 af = __builtin_bit_cast(bf16x8, w);
#pragma unroll
            for (int nt = 0; nt < 4; ++nt) { const bf16x8 bfr = *(const bf16x8*)(p.W2t + (size_t)sel * 64 * 128 + (size_t)(16 * nt + fr) * 128 + h); acc[nt] = __builtin_amdgcn_mfma_f32_16x16x32_bf16(af, bfr, acc[nt], 0, 0, 0); }
        }
#pragma unroll
        for (int r = 0; r < 4; ++r) { const int it = i0 + 4 * g + r; if (it < ntok) {
#pragma unroll
            for (int nt = 0; nt < 4; ++nt) dst[(size_t)it * 64 + 16 * nt + fr] = f2bf(acc[nt][r]); } }
    }
}

template <int HDV> __device__ __forceinline__ int vt_byte(int row, int col) { return row * (HDV * 2 + 32) + col * 2; }
constexpr int H_GL = 1024, H_QT = H_GL + 64 * 132 * 4, H_KT = H_QT + 16384, H_KE = H_KT + 16384, H_V = H_KE + 64 * 288, H_ST = H_V + 64 * 288, H_VEC = H_ST + 32768, H_END = H_VEC + 16 * 128 * 4;
static_assert(H_END <= 160 * 1024 - 64, "HGRN LDS map too large");

template <bool OUT> __device__ __forceinline__ void hgrn_task(const Params& p, int task, LAS unsigned char* lds) {
    const int tid = threadIdx.x, lane = tid & 63, w = tid >> 6, fr = lane & 15, g = lane >> 4;
    const int b = task >> 8, h = (task >> 5) & 7, sc = task & 31;
    const size_t row0 = (size_t)b * SEQ + sc * 256;
    LAS float* GL = (LAS float*)(lds + H_GL);
    LAS unsigned char* QT = lds + H_QT;
    LAS unsigned char* KT = lds + H_KT;
    LAS unsigned char* KE = lds + H_KE;
    LAS unsigned char* VV = lds + H_V;
    LAS unsigned char* ST = lds + H_ST;
    LAS float* VEC = (LAS float*)(lds + H_VEC);
    f32x4 sacc[8];
#pragma unroll
    for (int vt = 0; vt < 8; ++vt) sacc[vt] = (f32x4){0.f, 0.f, 0.f, 0.f};
    __syncthreads();
    if (OUT) {
        const float* S0 = p.Lloc + (size_t)task * 16384;
#pragma unroll
        for (int vt = 0; vt < 8; ++vt)
#pragma unroll
            for (int r = 0; r < 4; ++r) sacc[vt][r] = S0[(size_t)(16 * w + 4 * g + r) * 128 + 16 * vt + fr];
    } else if (tid < 128) VEC[9 * 128 + tid] = 0.f;
    for (int step = 0; step < 4; ++step) {
        const size_t r0 = row0 + step * 64;
        const int k = tid & 127, sub = tid >> 7;
        float gl[16], gr[16], gsum = 0.f;
#pragma unroll
        for (int i = 0; i < 16; ++i) gr[i] = p.G[(r0 + sub * 16 + i) * 1024 + h * 128 + k];
#pragma unroll
        for (int i = 0; i < 16; ++i) { gsum += gr[i]; gl[i] = gsum; }
        VEC[sub * 128 + k] = gsum;
        if (OUT) {
#pragma unroll
            for (int vt = 0; vt < 8; ++vt) { u32x2 wv; wv.x = cvt_pk_bf16(sacc[vt][0], sacc[vt][1]); wv.y = cvt_pk_bf16(sacc[vt][2], sacc[vt][3]); *(LAS u32x2*)(ST + ktile_byte<128>(16 * vt + fr, 16 * w + 4 * g)) = wv; }
        }
        {
            const int s = tid >> 3, ch = tid & 7;
            const u32x4 a = *(const u32x4*)(p.HV + (r0 + s) * 1024 + h * 128 + ch * 16), b2 = *(const u32x4*)(p.HV + (r0 + s) * 1024 + h * 128 + ch * 16 + 8);
            *(LAS u32x4*)(VV + vt_byte<128>(s, ch * 16)) = a; *(LAS u32x4*)(VV + vt_byte<128>(s, ch * 16 + 8)) = b2;
        }
        __syncthreads();
        {
            float bi = 0.f, gend = 0.f;
#pragma unroll
            for (int i = 0; i < 4; ++i) { const float tv = VEC[i * 128 + k]; if (i < sub) bi += tv; gend += tv; }
            const float gmid = gl[7];
            if (sub == 0) { VEC[8 * 128 + k] = gend; }
            VEC[(4 + sub) * 128 + k] = bi + gmid;
            const float etail = gend - bi;
#pragma unroll
            for (int i = 0; i < 16; ++i) {
                const int t = sub * 16 + i;
                const float kk = 1.0f - fast_exp(gr[i]);
                if (OUT) { const float qv = bf2f(p.HQ[(r0 + t) * 1024 + h * 128 + k]);
                    *(LAS bf16_t*)(QT + ktile_byte<128>(t, k)) = f2bf(qv * fast_exp(gl[i] - gmid));
                    *(LAS bf16_t*)(KT + ktile_byte<128>(t, k)) = f2bf(kk * fast_exp(gmid - gl[i])); }
                *(LAS bf16_t*)(KE + vt_byte<128>(t, k)) = f2bf(kk * fast_exp(etail - gl[i]));
            }
        }
        __syncthreads();
        if (OUT) {
            const int ti = w & 3, vh = w >> 2;
            bf16x8 qf[4]; float rti[4][8];
#pragma unroll
            for (int ks = 0; ks < 4; ++ks) { qf[ks] = *(const LAS bf16x8*)(QT + ktile_byte<128>(16 * ti + fr, 32 * ks + 8 * g));
#pragma unroll
                for (int j = 0; j < 8; ++j) rti[ks][j] = VEC[(4 + ti) * 128 + 32 * ks + 8 * g + j]; }
            f32x4 at[4];
#pragma unroll
            for (int sj = 0; sj < 4; ++sj) { at[sj] = (f32x4){0.f, 0.f, 0.f, 0.f};
                if (sj <= ti) {
#pragma unroll
                    for (int ks = 0; ks < 4; ++ks) {
                        bf16x8 qs = qf[ks];
                        if (sj < ti) { float f[8];
#pragma unroll
                            for (int j = 0; j < 8; ++j) f[j] = bf2f((bf16_t)qf[ks][j]) * fast_exp(rti[ks][j] - VEC[(4 + sj) * 128 + 32 * ks + 8 * g + j]);
                            u32x4 wv; wv.x = cvt_pk_bf16(f[0], f[1]); wv.y = cvt_pk_bf16(f[2], f[3]); wv.z = cvt_pk_bf16(f[4], f[5]); wv.w = cvt_pk_bf16(f[6], f[7]); qs = __builtin_bit_cast(bf16x8, wv); }
                        const bf16x8 kf = *(const LAS bf16x8*)(KT + ktile_byte<128>(16 * sj + fr, 32 * ks + 8 * g));
                        at[sj] = __builtin_amdgcn_mfma_f32_16x16x32_bf16(kf, qs, at[sj], 0, 0, 0);
                    }
                    if (sj == ti) {
#pragma unroll
                        for (int r = 0; r < 4; ++r) if (4 * g + r > fr) at[sj][r] = 0.f;
                    }
                } }
            bf16x8 pf[2];
#pragma unroll
            for (int ph = 0; ph < 2; ++ph) { u32x4 wv; wv.x = cvt_pk_bf16(at[2 * ph][0], at[2 * ph][1]); wv.y = cvt_pk_bf16(at[2 * ph][2], at[2 * ph][3]);
                wv.z = cvt_pk_bf16(at[2 * ph + 1][0], at[2 * ph + 1][1]); wv.w = cvt_pk_bf16(at[2 * ph + 1][2], at[2 * ph + 1][3]); pf[ph] = __builtin_bit_cast(bf16x8, wv); }
            bf16x8 qin[4];
#pragma unroll
            for (int ks = 0; ks < 4; ++ks) { float f[8];
#pragma unroll
                for (int j = 0; j < 8; ++j) f[j] = bf2f((bf16_t)qf[ks][j]) * fast_exp(rti[ks][j]);
                u32x4 wv; wv.x = cvt_pk_bf16(f[0], f[1]); wv.y = cvt_pk_bf16(f[2], f[3]); wv.z = cvt_pk_bf16(f[4], f[5]); wv.w = cvt_pk_bf16(f[6], f[7]); qin[ks] = __builtin_bit_cast(bf16x8, wv); }
            f32x4 ot[4]; float ss = 0.f;
#pragma unroll
            for (int vi = 0; vi < 4; ++vi) { const int vt = 4 * vh + vi; ot[vi] = (f32x4){0.f, 0.f, 0.f, 0.f};
#pragma unroll
                for (int ks = 0; ks < 4; ++ks) { const bf16x8 sf = *(const LAS bf16x8*)(ST + ktile_byte<128>(16 * vt + fr, 32 * ks + 8 * g)); ot[vi] = __builtin_amdgcn_mfma_f32_16x16x32_bf16(sf, qin[ks], ot[vi], 0, 0, 0); }
#pragma unroll
                for (int ph = 0; ph < 2; ++ph) { if (2 * ph > ti) continue;
                    const LAS unsigned char* vb = VV + vt_byte<128>(32 * ph + 4 * g + (fr >> 2), 16 * vt + 4 * (fr & 3));
                    const s16x4 a = __builtin_amdgcn_ds_read_tr16_b64_v4i16((LAS s16x4*)vb), b2 = __builtin_amdgcn_ds_read_tr16_b64_v4i16((LAS s16x4*)(vb + 16 * 288));
                    const bf16x8 vf = {a[0], a[1], a[2], a[3], b2[0], b2[1], b2[2], b2[3]};
                    ot[vi] = __builtin_amdgcn_mfma_f32_16x16x32_bf16(vf, pf[ph], ot[vi], 0, 0, 0); }
                ss += ot[vi][0] * ot[vi][0] + ot[vi][1] * ot[vi][1] + ot[vi][2] * ot[vi][2] + ot[vi][3] * ot[vi][3];
            }
            ss = xsum16_32(ss);
            if (g == 0) VEC[(10 + vh) * 128 + 16 * ti + fr] = ss;
            __syncthreads();
            {
                const float tot = VEC[10 * 128 + 16 * ti + fr] + VEC[11 * 128 + 16 * ti + fr];
                const float rs = rsqrtf(tot * (1.0f / 128.0f) + RMS_EPS);
                const size_t row = r0 + 16 * ti + fr;
#pragma unroll
                for (int vi = 0; vi < 4; ++vi) { const int v0 = 16 * (4 * vh + vi) + 4 * g; const f32x4 gn = *(const f32x4*)(p.hg_gnorm + v0);
                    const u32x2 og = *(const u32x2*)(p.HOG + row * 1024 + h * 128 + v0);
                    u32x2 wv; wv.x = cvt_pk_bf16(ot[vi][0] * rs * gn[0] * lo_bf(og.x), ot[vi][1] * rs * gn[1] * hi_bf(og.x)); wv.y = cvt_pk_bf16(ot[vi][2] * rs * gn[2] * lo_bf(og.y), ot[vi][3] * rs * gn[3] * hi_bf(og.y));
                    *(u32x2*)(p.OHG + row * 1024 + h * 128 + v0) = wv; }
            }
        }
        {
            float dk[4];
#pragma unroll
            for (int r = 0; r < 4; ++r) dk[r] = fast_exp(VEC[8 * 128 + 16 * w + 4 * g + r]);
#pragma unroll
            for (int vt = 0; vt < 8; ++vt)
#pragma unroll
                for (int r = 0; r < 4; ++r) sacc[vt][r] *= dk[r];
#pragma unroll
            for (int ks = 0; ks < 2; ++ks) {
                const LAS unsigned char* kb = KE + vt_byte<128>(32 * ks + 8 * g + (fr >> 2), 16 * w + 4 * (fr & 3));
                const s16x4 ka = __builtin_amdgcn_ds_read_tr16_b64_v4i16((LAS s16x4*)kb), kb2 = __builtin_amdgcn_ds_read_tr16_b64_v4i16((LAS s16x4*)(kb + 4 * 288));
                const bf16x8 kf = {ka[0], ka[1], ka[2], ka[3], kb2[0], kb2[1], kb2[2], kb2[3]};
#pragma unroll
                for (int vt = 0; vt < 8; ++vt) {
                    const LAS unsigned char* vb = VV + vt_byte<128>(32 * ks + 8 * g + (fr >> 2), 16 * vt + 4 * (fr & 3));
                    const s16x4 va = __builtin_amdgcn_ds_read_tr16_b64_v4i16((LAS s16x4*)vb), vb2 = __builtin_amdgcn_ds_read_tr16_b64_v4i16((LAS s16x4*)(vb + 4 * 288));
                    const bf16x8 vf = {va[0], va[1], va[2], va[3], vb2[0], vb2[1], vb2[2], vb2[3]};
                    sacc[vt] = __builtin_amdgcn_mfma_f32_16x16x32_bf16(kf, vf, sacc[vt], 0, 0, 0);
                }
            }
            if (!OUT && tid < 128) VEC[9 * 128 + tid] += VEC[8 * 128 + tid];
        }
        __syncthreads();
    }
    if (!OUT) {
        float* L = p.Lloc + (size_t)task * 16384;
#pragma unroll
        for (int vt = 0; vt < 8; ++vt)
#pragma unroll
            for (int r = 0; r < 4; ++r) L[(size_t)(16 * w + 4 * g + r) * 128 + 16 * vt + fr] = sacc[vt][r];
        if (tid < 128) p.Dec[(size_t)task * 128 + tid] = fast_exp(VEC[9 * 128 + tid]);
    }
}

__device__ __forceinline__ void hgrn_scan(const Params& p) {
    const int e0 = (blockIdx.x * 512 + threadIdx.x) * 2;
    if (e0 >= 16 * 16384) return;
    const int bh = e0 >> 14, kvx = e0 & 16383, k = kvx >> 7;
    f32x2 S = (f32x2){0.f, 0.f};
    for (int sc = 0; sc < 32; ++sc) {
        const size_t task = (size_t)bh * 32 + sc;
        f32x2* Lp = (f32x2*)(p.Lloc + task * 16384 + kvx);
        const f32x2 L = *Lp; const float d = p.Dec[task * 128 + k];
        *Lp = S;
        S = S * d + L;
    }
    *(f32x2*)(p.out + OFF_PSTATE + (size_t)bh * 16384 + kvx) = S;
}

__device__ __forceinline__ void hgrn_sample_task(const Params& p, int task, LAS unsigned char* lds) {
    const int tid = threadIdx.x, v = tid & 127, kq = tid >> 7, b = task >> 3, h = task & 7;
    LAS float* FV = (LAS float*)(lds + 1024);
    LAS float* QV = FV + 1024;
    LAS float* PART = QV + 1024;
    LAS float* RS = PART + 4096;
    __syncthreads();
    for (int i = tid; i < 1024; i += 512) { const size_t row = (size_t)MP + b * 8 + (i >> 7); const int k = i & 127;
        FV[i] = fast_exp(p.G[row * 1024 + h * 128 + k]); QV[i] = bf2f(p.HQ[row * 1024 + h * 128 + k]); }
    const float* S0 = p.state_hgrn + ((size_t)(b * 8 + h) * 128 + kq * 32) * 128 + v;
    float s[32];
#pragma unroll
    for (int j = 0; j < 32; ++j) s[j] = S0[(size_t)j * 128];
    __syncthreads();
#pragma unroll 1
    for (int i = 0; i < 8; ++i) {
        const size_t row = (size_t)MP + b * 8 + i;
        const float vv = bf2f(p.HV[row * 1024 + h * 128 + v]);
        float o = 0.f;
#pragma unroll
        for (int j = 0; j < 32; ++j) { const float f = FV[i * 128 + kq * 32 + j]; s[j] = f * s[j] + (1.0f - f) * vv; o += QV[i * 128 + kq * 32 + j] * s[j]; }
        PART[(kq * 8 + i) * 128 + v] = o;
    }
    float* S1 = p.out + OFF_SSTATE + ((size_t)(b * 8 + h) * 128 + kq * 32) * 128 + v;
#pragma unroll
    for (int j = 0; j < 32; ++j) S1[(size_t)j * 128] = s[j];
    __syncthreads();
    {
        const int i = tid >> 6, l = tid & 63;
        float o0 = 0.f, o1 = 0.f;
#pragma unroll
        for (int q = 0; q < 4; ++q) { o0 += PART[(q * 8 + i) * 128 + l]; o1 += PART[(q * 8 + i) * 128 + 64 + l]; }
        float ss = o0 * o0 + o1 * o1;
#pragma unroll
        for (int d = 1; d < 64; d <<= 1) ss += __shfl_xor(ss, d);
        const float rs = rsqrtf(ss * (1.0f / 128.0f) + RMS_EPS);
        const size_t row = (size_t)MP + b * 8 + i;
        p.OHG[row * 1024 + h * 128 + l] = f2bf(o0 * rs * p.hg_gnorm[l] * bf2f(p.HOG[row * 1024 + h * 128 + l]));
        p.OHG[row * 1024 + h * 128 + 64 + l] = f2bf(o1 * rs * p.hg_gnorm[64 + l] * bf2f(p.HOG[row * 1024 + h * 128 + 64 + l]));
    }
    (void)RS;
}
constexpr float MEM_C = 0.0625f * 1.44269504088896f;
constexpr int X_KT = 1024, X_VT = X_KT + 32768;
__device__ __forceinline__ void xattn_unit_prompt(const Params& p, int unit, LAS unsigned char* lds) {
    const int b = unit >> 8, head = (unit >> 6) & 3, qb = unit & 63;
    const int lane = threadIdx.x & 63, w = threadIdx.x >> 6, fr = lane & 15, g = lane >> 4;
    AttnTile<256> T[1]; const bool act[1] = {true}; T[0].init();
    const size_t row = (size_t)b * SEQ + qb * 128 + 16 * w + fr;
#pragma unroll
    for (int ds = 0; ds < 8; ++ds) T[0].q[ds] = *(const bf16x8*)(p.QM + row * 1024 + head * 256 + 32 * ds + 8 * g);
    LAS unsigned char* Kt = lds + X_KT; LAS unsigned char* Vt = lds + X_VT;
    for (int kb = 0; kb < 4; ++kb) {
        __syncthreads();
#pragma unroll
        for (int i = 0; i < 4; ++i) { const int c = threadIdx.x + 512 * i, key = c >> 5, ch = c & 31;
            const bf16_t* src = p.MKVp + (size_t)(b * MEMT + kb * 64 + key) * 2048 + head * 256 + ch * 8;
            *(LAS u32x4*)(Kt + ktile_byte<256>(key, ch * 8)) = *(const u32x4*)src;
            *(LAS u32x4*)(Vt + key * vstride<256>() + ch * 16) = *(const u32x4*)(src + 1024); }
        __syncthreads();
        attn_block<256, 1>(T, act, Kt, Vt, MEM_C, false, [&](int, int) { return true; }, lane);
    }
    attn_store_bf16<256>(T[0], p.OM + row * 1024 + head * 256, lane);
}
__device__ __forceinline__ void xattn_unit_sample(const Params& p, int unit, LAS unsigned char* lds) {
    const int b = unit >> 2, head = unit & 3;
    const int lane = threadIdx.x & 63, w = threadIdx.x >> 6, fr = lane & 15, g = lane >> 4;
    AttnTile<256> T[1]; const bool act[1] = {w == 0}; T[0].init();
    const size_t row = (size_t)MP + b * 8 + (fr & 7);
#pragma unroll
    for (int ds = 0; ds < 8; ++ds) T[0].q[ds] = *(const bf16x8*)(p.QM + row * 1024 + head * 256 + 32 * ds + 8 * g);
    LAS unsigned char* Kt = lds + X_KT; LAS unsigned char* Vt = lds + X_VT;
    for (int kb = 0; kb < 4; ++kb) {
        __syncthreads();
#pragma unroll
        for (int i = 0; i < 4; ++i) { const int c = threadIdx.x + 512 * i, key = c >> 5, ch = c & 31;
            const float* src = p.cache_mem + (size_t)(b * MEMT + kb * 64 + key) * 2048 + head * 256 + ch * 8;
            *(LAS u32x4*)(Kt + ktile_byte<256>(key, ch * 8)) = pack8(*(const f32x4*)src, *(const f32x4*)(src + 4));
            *(LAS u32x4*)(Vt + key * vstride<256>() + ch * 16) = pack8(*(const f32x4*)(src + 1024), *(const f32x4*)(src + 1028)); }
        __syncthreads();
        if (w == 0) attn_block<256, 1>(T, act, Kt, Vt, MEM_C, false, [&](int, int) { return true; }, lane);
    }
    if (w == 0) {
        const int gg = lane >> 4; const float inv = 1.0f / fmaxf(xsum16_32(T[0].l), 1e-30f);
        if (fr < 8) {
#pragma unroll
            for (int dt = 0; dt < 16; ++dt) { u32x2 wv; wv.x = cvt_pk_bf16(T[0].o[dt][0] * inv, T[0].o[dt][1] * inv); wv.y = cvt_pk_bf16(T[0].o[dt][2] * inv, T[0].o[dt][3] * inv);
                *(u32x2*)(p.OM + row * 1024 + head * 256 + 16 * dt + 4 * gg) = wv; }
        }
    }
}

__device__ __forceinline__ void row_stats(const float* st, int row, float& mean, float& rstd) {
    const f32x2 s = *(const f32x2*)(st + (size_t)row * 2); mean = s.x * (1.0f / 1024.0f); const float var = fmaxf(s.y * (1.0f / 1024.0f) - mean * mean, 0.f); rstd = rsqrtf(var + LN_EPS);
}
struct EpiRes {
    static constexpr bool PERM = true, AFTER_DRAIN = false;
    int mode; const float* xp; const float* xs; const float* zprev; const float* stprev; const float* gain; const float* bias; float* Z; bf16_t* Zb; float* st;
    __device__ __forceinline__ void operator()(const f32x4 (&acc)[2][2][4][2], const pg8::Unit& u, int wr, int wc, int fr, int fq) const {
#pragma unroll
        for (int ai = 0; ai < 2; ++ai)
#pragma unroll
            for (int m = 0; m < 4; ++m) {
                const int row = u.pm * 256 + ai * 128 + wr * 64 + m * 16 + fr;
                float mean = 0.f, rstd = 1.f; if (mode == 1) row_stats(stprev, row, mean, rstd);
                const float* rsrc = (mode == 0) ? (row < MP ? xp + (size_t)row * 1024 : xs + (size_t)(row - MP) * 1024) : zprev + (size_t)row * 1024;
                float s1 = 0.f, s2 = 0.f;
#pragma unroll
                for (int bj = 0; bj < 2; ++bj) {
                    const int col = u.pn * 256 + bj * 128 + wc * 32 + 8 * fq;
                    f32x4 x0 = *(const f32x4*)(rsrc + col), x1 = *(const f32x4*)(rsrc + col + 4);
                    if (mode == 1) { const f32x4 g0 = *(const f32x4*)(gain + col), g1 = *(const f32x4*)(gain + col + 4), b0 = *(const f32x4*)(bias + col), b1 = *(const f32x4*)(bias + col + 4);
                        x0 = (x0 - mean) * rstd * g0 + b0; x1 = (x1 - mean) * rstd * g1 + b1; }
                    const f32x4 z0 = x0 * DN_ALPHA + acc[ai][bj][m][0], z1 = x1 * DN_ALPHA + acc[ai][bj][m][1];
                    float* d = Z + (size_t)row * 1024 + col; *(f32x4*)d = z0; *(f32x4*)(d + 4) = z1;
                    if (Zb) *(u32x4*)(Zb + (size_t)row * 1024 + col) = pack8(z0, z1);
#pragma unroll
                    for (int j = 0; j < 4; ++j) { s1 += z0[j] + z1[j]; s2 += z0[j] * z0[j] + z1[j] * z1[j]; }
                }
                s1 = xsum16_32(s1); s2 = xsum16_32(s2);
                if (fq == 0) { atomicAdd(st + (size_t)row * 2, s1); atomicAdd(st + (size_t)row * 2 + 1, s2); }
            }
    }
};
struct EpiLnIn {
    static constexpr bool PERM = true, AFTER_DRAIN = false;
    int act; const float* st; const float* cs; const float* bw; bf16_t* O; int ldo;
    __device__ __forceinline__ void operator()(const f32x4 (&acc)[2][2][4][2], const pg8::Unit& u, int wr, int wc, int fr, int fq) const {
#pragma unroll
        for (int ai = 0; ai < 2; ++ai)
#pragma unroll
            for (int m = 0; m < 4; ++m) {
                const int row = u.pm * 256 + ai * 128 + wr * 64 + m * 16 + fr;
                float mean, rstd; row_stats(st, row, mean, rstd);
#pragma unroll
                for (int bj = 0; bj < 2; ++bj) {
                    const int col = u.pn * 256 + bj * 128 + wc * 32 + 8 * fq;
                    const f32x4 c0 = *(const f32x4*)(cs + col), c1 = *(const f32x4*)(cs + col + 4), b0 = *(const f32x4*)(bw + col), b1 = *(const f32x4*)(bw + col + 4);
                    f32x4 y0 = (acc[ai][bj][m][0] - c0 * mean) * rstd + b0, y1 = (acc[ai][bj][m][1] - c1 * mean) * rstd + b1;
                    if (act == 1) {
#pragma unroll
                        for (int j = 0; j < 4; ++j) { const float a = fmaxf(y0[j], 0.f), b2 = fmaxf(y1[j], 0.f); y0[j] = a * a; y1[j] = b2 * b2; } }
                    *(u32x4*)(O + (size_t)row * ldo + col) = pack8(y0, y1);
                }
            }
    }
};
template <class Epi> __device__ __forceinline__ void run_gemm(LAS unsigned char* lds, const bf16_t* A, int lda, const bf16_t* Bt, int M, int N, int K, const Epi& E) {
    pg8::Gemm g{A, Bt, M, N, K, lda};
    pg8::StaticOrder S; S.init(M, N, gridDim.x, blockIdx.x);
    pg8::gemm_phase<Epi, pg8::StaticOrder, false>(lds, g, S, E, nullptr);
}
__device__ __forceinline__ void final_ln(const Params& p) {
    const int lane = threadIdx.x & 63, gw = blockIdx.x * 8 + (threadIdx.x >> 6), nw = gridDim.x * 8;
    const float* gain = p.ln_g + 2048; const float* bias = p.ln_b + 2048;
    for (int row = gw; row < MT; row += nw) {
        float mean, rstd; row_stats(p.stats3, row, mean, rstd);
        float* z = p.out + (size_t)row * 1024;
#pragma unroll
        for (int i = 0; i < 4; ++i) { const int c = (i * 64 + lane) * 4; const f32x4 v = *(const f32x4*)(z + c), g4 = *(const f32x4*)(gain + c), b4 = *(const f32x4*)(bias + c); *(f32x4*)(z + c) = (v - mean) * rstd * g4 + b4; }
    }
}

__device__ __forceinline__ void phase_mix1(const Params& p, LAS unsigned char* lds) {
    {
        EpiPlain E{p.out + OFF_PMEM, 2048, p.MKVp, 2048};
        run_gemm(lds, p.Memb, DM, p.Wt_mkv, NBATCH * MEMT, 2048, DM, E);
    }
    {
        pg8::Gemm g{p.CKp, p.W1t, 139264, 512, 1024, 1024};
        CmpOrder S{(int)gridDim.x, (int)blockIdx.x}; EpiCmp E{p.CCp};
        pg8::gemm_phase<EpiCmp, CmpOrder, false>(lds, g, S, E, nullptr);
    }
    for (int u = blockIdx.x; u < 1024; u += gridDim.x) win_unit_prompt(p, u, lds);
    for (int u = blockIdx.x; u < 512; u += gridDim.x) win_unit_sample(p, u, lds);
    for (int t = blockIdx.x; t < 512; t += gridDim.x) hgrn_task<false>(p, t, lds);
    for (int t = blockIdx.x; t < 1024; t += gridDim.x) hgrn_sample_task(p, t, lds);
}
__device__ __forceinline__ void phase_mix2(const Params& p, LAS unsigned char* lds) { hgrn_scan(p); cmp_stage2(p); }
__device__ __forceinline__ void phase_mix3(const Params& p, LAS unsigned char* lds) {
    for (int t = blockIdx.x; t < 512; t += gridDim.x) hgrn_task<true>(p, t, lds);
    for (int u = blockIdx.x; u < 1024; u += gridDim.x) cmp_unit(p, false, u, lds);
    for (int u = blockIdx.x; u < 512; u += gridDim.x) cmp_unit(p, true, u, lds);
}
__device__ __forceinline__ void phase_slc(const Params& p, LAS unsigned char* lds) {
    for (int u = blockIdx.x; u < 1024; u += gridDim.x) slc_unit(p, false, u, lds);
    for (int u = blockIdx.x; u < 512; u += gridDim.x) slc_unit(p, true, u, lds);
}
__device__ __forceinline__ void phase_wout(const Params& p, LAS unsigned char* lds) {
    EpiRes E{0, p.x_prompt, p.x_sample, nullptr, nullptr, nullptr, nullptr, p.Z1, p.Z1b, p.stats1};
    run_gemm(lds, p.MERGED, DM, p.Wt_out, MT, DM, DM, E);
}
__device__ __forceinline__ void phase_mq(const Params& p, LAS unsigned char* lds) {
    EpiLnIn E{0, p.stats1, p.cs_mq, p.bw_mq, p.QM, 1024};
    run_gemm(lds, p.Z1b, DM, p.Wt_mq, MT, DM, DM, E);
}
__device__ __forceinline__ void phase_xattn(const Params& p, LAS unsigned char* lds) {
    for (int u = blockIdx.x; u < 512; u += gridDim.x) xattn_unit_prompt(p, u, lds);
    for (int u = blockIdx.x; u < 512; u += gridDim.x) xattn_unit_sample(p, u, lds);
}
__device__ __forceinline__ void phase_mo(const Params& p, LAS unsigned char* lds) {
    EpiRes E{1, nullptr, nullptr, p.Z1, p.stats1, p.ln_g, p.ln_b, p.Z2, p.Z2b, p.stats2};
    run_gemm(lds, p.OM, DM, p.Wt_mo, MT, DM, DM, E);
}
__device__ __forceinline__ void phase_up(const Params& p, LAS unsigned char* lds) {
    EpiLnIn E{1, p.stats2, p.cs_up, p.bw_up, p.Hb, DFF};
    run_gemm(lds, p.Z2b, DM, p.Wt_up, MT, DFF, DM, E);
}
__device__ __forceinline__ void phase_down(const Params& p, LAS unsigned char* lds) {
    EpiRes E{1, nullptr, nullptr, p.Z2, p.stats2, p.ln_g + 1024, p.ln_b + 1024, p.out, nullptr, p.stats3};
    run_gemm(lds, p.Hb, DFF, p.Wt_down, MT, DM, DFF, E);
}
constexpr int LDS_BYTES = 160 * 1024;
constexpr int NTHREADS = 512;

template <int PH> __device__ __forceinline__ void run_phase(const Params& p, LAS unsigned char* lds) {
    if constexpr (PH == 0) phase_prologue(p, lds);
    else if constexpr (PH == 1) phase_gemm1(p, lds);
    else if constexpr (PH == 2) phase_mix1(p, lds);
    else if constexpr (PH == 3) phase_mix2(p, lds);
    else if constexpr (PH == 4) phase_mix3(p, lds);
    else if constexpr (PH == 5) phase_slc(p, lds);
    else if constexpr (PH == 6) phase_wout(p, lds);
    else if constexpr (PH == 7) phase_mq(p, lds);
    else if constexpr (PH == 8) phase_xattn(p, lds);
    else if constexpr (PH == 9) phase_mo(p, lds);
    else if constexpr (PH == 10) phase_up(p, lds);
    else if constexpr (PH == 11) phase_down(p, lds);
    else if constexpr (PH == 12) final_ln(p);
    else if constexpr (PH == 13) { for (size_t i = (size_t)blockIdx.x * 512 + threadIdx.x; i < (size_t)MT * 256; i += (size_t)gridDim.x * 512) ((f32x4*)p.out)[i] = (f32x4){0.f, 0.f, 0.f, 0.f}; }
}

template <int PH> __global__ void __launch_bounds__(NTHREADS, 2) k_phase(Params p) {
    extern __shared__ __attribute__((aligned(16))) unsigned char smem[];
    run_phase<PH>(p, (LAS unsigned char*)smem);
}

struct WsAlloc { char* base; size_t off; template <class T> T* get(size_t n) { T* r = (T*)(base + off); off += (n * sizeof(T) + 255) & ~(size_t)255; return r; } };

template <int PH> static void launch_phase(const Params& p, hipStream_t stream) {
    static bool attr = false;
    if (!attr) { (void)hipFuncSetAttribute((const void*)k_phase<PH>, hipFuncAttributeMaxDynamicSharedMemorySize, LDS_BYTES); attr = true; }
    hipLaunchKernelGGL(k_phase<PH>, dim3(256), dim3(NTHREADS), LDS_BYTES, stream, p);
}

extern "C" void kernel_launch(void* const* d_in, const int* in_sizes, int n_in, void* d_out, int out_size, void* d_ws, size_t ws_size, hipStream_t stream) {
    Params p{};
    p.x_prompt = (const float*)d_in[0]; p.x_sample = (const float*)d_in[1]; p.state_hgrn = (const float*)d_in[2]; p.cache_cmp = (const float*)d_in[3];
    p.cache_slc = (const float*)d_in[4]; p.cache_win = (const float*)d_in[5]; p.cache_mem = (const float*)d_in[6]; p.page_table = (const int*)d_in[7];
    p.mem_prompt = (const float*)d_in[8]; p.w_in = (const float*)d_in[9]; p.w_out = (const float*)d_in[10]; p.hg_lb = (const float*)d_in[11];
    p.hg_gnorm = (const float*)d_in[12]; p.cmp_pe = (const float*)d_in[13]; p.cmp_w1 = (const float*)d_in[14]; p.cmp_w2 = (const float*)d_in[15];
    p.w_mq = (const float*)d_in[16]; p.w_mkv = (const float*)d_in[17]; p.w_mo = (const float*)d_in[18]; p.w_up = (const float*)d_in[19];
    p.w_down = (const float*)d_in[20]; p.ln_g = (const float*)d_in[21]; p.ln_b = (const float*)d_in[22];
    p.out = (float*)d_out;
    WsAlloc W{(char*)d_ws, 0};
    p.bar = W.get<unsigned>(4096); p.stats1 = W.get<float>((size_t)MT * 2); p.stats2 = W.get<float>((size_t)MT * 2); p.stats3 = W.get<float>((size_t)MT * 2);
    p.cs_mq = W.get<float>(1024); p.bw_mq = W.get<float>(1024); p.cs_up = W.get<float>(4096); p.bw_up = W.get<float>(4096); p.posb = W.get<float>(256);
    const size_t zero_bytes = W.off;
    p.Wt_in = W.get<bf16_t>((size_t)NINP * DM); p.Wt_out = W.get<bf16_t>((size_t)DM * DM); p.Wt_mq = W.get<bf16_t>((size_t)DM * DM); p.Wt_mkv = W.get<bf16_t>((size_t)2 * DM * DM);
    p.Wt_mo = W.get<bf16_t>((size_t)DM * DM); p.Wt_up = W.get<bf16_t>((size_t)DFF * DM); p.Wt_down = W.get<bf16_t>((size_t)DM * DFF);
    p.W1t = W.get<bf16_t>((size_t)2 * 256 * 1024); p.W2t = W.get<bf16_t>((size_t)2 * 64 * 128);
    p.lbv = W.get<float>(1024); p.rope = W.get<float>((size_t)SEQ * 64);
    p.Xb = W.get<bf16_t>((size_t)MT * DM); p.Memb = W.get<bf16_t>((size_t)NBATCH * MEMT * DM);
    p.HQ = W.get<bf16_t>((size_t)MT * DM); p.HV = W.get<bf16_t>((size_t)MT * DM); p.HOG = W.get<bf16_t>((size_t)MT * DM); p.QN = W.get<bf16_t>((size_t)MT * DM);
    p.QR = W.get<bf16_t>((size_t)MT * DM); p.GA = W.get<bf16_t>((size_t)MT * DM); p.GB = W.get<bf16_t>((size_t)MT * DM);
    p.G = W.get<float>((size_t)MT * DM); p.NG = W.get<float>((size_t)MT * 48);
    p.CKp = W.get<bf16_t>((size_t)4 * MP * 64); p.CKs = W.get<bf16_t>((size_t)4 * DBATCH * PAST * 64);
    p.CVp = W.get<bf16_t>((size_t)4 * MP * 64); p.CVs = W.get<bf16_t>((size_t)4 * DBATCH * PAST * 64);
    p.SKp = W.get<bf16_t>((size_t)4 * MP * 64); p.SVp = W.get<bf16_t>((size_t)4 * MP * 64); p.WKp = W.get<bf16_t>((size_t)4 * MP * 64); p.WVp = W.get<bf16_t>((size_t)4 * MP * 64);
    p.SKs = W.get<bf16_t>((size_t)4 * MS * 64); p.SVs = W.get<bf16_t>((size_t)4 * MS * 64); p.WKs = W.get<bf16_t>((size_t)4 * MS * 64); p.WVs = W.get<bf16_t>((size_t)4 * MS * 64);
    p.MKVp = W.get<bf16_t>((size_t)NBATCH * MEMT * 2048);
    p.CCp = W.get<float>((size_t)2 * 4096 * 256); p.CCs = W.get<float>((size_t)2 * 65536 * 256);
    p.KCp = W.get<bf16_t>((size_t)NBATCH * 4 * 512 * 64); p.VCp = W.get<bf16_t>((size_t)NBATCH * 4 * 512 * 64);
    p.KCs = W.get<bf16_t>((size_t)DBATCH * 4 * 128 * 64); p.VCs = W.get<bf16_t>((size_t)DBATCH * 4 * 128 * 64);
    p.Lloc = W.get<float>((size_t)512 * 128 * 128); p.Dec = W.get<float>((size_t)512 * 128); p.Sst = W.get<bf16_t>((size_t)512 * 128 * 128);
    p.OHG = W.get<bf16_t>((size_t)MT * DM); p.OWIN = W.get<bf16_t>((size_t)MT * DM); p.OCMP = W.get<bf16_t>((size_t)MT * DM); p.MERGED = W.get<bf16_t>((size_t)MT * DM);
    p.SEL = W.get<unsigned>((size_t)MT * 16);
    p.Z1 = W.get<float>((size_t)MT * DM); p.Z2 = W.get<float>((size_t)MT * DM); p.Z1b = W.get<bf16_t>((size_t)MT * DM); p.Z2b = W.get<bf16_t>((size_t)MT * DM);
    p.QM = W.get<bf16_t>((size_t)MT * DM); p.OM = W.get<bf16_t>((size_t)MT * DM); p.Hb = W.get<bf16_t>((size_t)MT * DFF);
    if (W.off > ws_size) { fprintf(stderr, "workspace too small: need %zu have %zu\n", W.off, ws_size); return; }
    (void)hipMemsetAsync(d_ws, 0, zero_bytes, stream);
    launch_phase<0>(p, stream); launch_phase<1>(p, stream); launch_phase<2>(p, stream); launch_phase<3>(p, stream); launch_phase<4>(p, stream);
    launch_phase<5>(p, stream); launch_phase<6>(p, stream); launch_phase<7>(p, stream); launch_phase<8>(p, stream); launch_phase<9>(p, stream);
    launch_phase<10>(p, stream); launch_phase<11>(p, stream); launch_phase<12>(p, stream);
}
```

```cpp
#include <hip/hip_runtime.h>
#include <stdint.h>
#include <stdio.h>

#define LAS __attribute__((address_space(3)))
typedef unsigned short bf16_t;
typedef short bf16x8 __attribute__((ext_vector_type(8)));
typedef short bf16x4 __attribute__((ext_vector_type(4)));
typedef float f32x4 __attribute__((ext_vector_type(4)));
typedef float f32x2 __attribute__((ext_vector_type(2)));
typedef unsigned u32x4 __attribute__((ext_vector_type(4)));
typedef unsigned u32x2 __attribute__((ext_vector_type(2)));

constexpr int DM = 1024, SEQ = 8192, NBATCH = 2, MP = NBATCH * SEQ, DBATCH = 128, DSEQ = 8, MS = DBATCH * DSEQ, MT = MP + MS;
constexpr int PAST = 2048, PAGE = 128, NPAGES = PAST / PAGE, WIN = 512, MEMT = 256;
constexpr int NIN = 8752, NINP = 8960, DFF = 4096;
constexpr int NCMP_P = SEQ / 16 - 1  , NCMP_S = PAST / 16 - 1  ;
constexpr float LN_EPS = 1e-5f, RMS_EPS = 1e-6f;
constexpr float DN_ALPHA = 1.18920711500272f;
constexpr size_t OFF_Y = 0, OFF_PSTATE = 17825792, OFF_PCMP = 18087936, OFF_PSLC = 26476544, OFF_PWIN = 34865152, OFF_PMEM = 35389440,
                 OFF_SSTATE = 36438016, OFF_SCMP = 53215232, OFF_SSLC = 53739520, OFF_SWIN = 54263808;

__device__ __forceinline__ float bf2f(bf16_t v) { return __uint_as_float((unsigned)v << 16); }
typedef __bf16 bf16x2_t __attribute__((ext_vector_type(2)));
__device__ __forceinline__ unsigned cvt_pk_bf16(float lo, float hi) { const f32x2 v = {lo, hi}; return __builtin_bit_cast(unsigned, __builtin_convertvector(v, bf16x2_t)); }
__device__ __forceinline__ bf16_t f2bf(float f) { return (bf16_t)(cvt_pk_bf16(f, 0.f) & 0xffffu); }
__device__ __forceinline__ float fast_exp(float x) { return __builtin_amdgcn_exp2f(x * 1.44269504088896f); }
__device__ __forceinline__ float sigmoidf_(float x) { return __builtin_amdgcn_rcpf(1.0f + fast_exp(-x)); }
__device__ __forceinline__ float siluf_(float x) { return x * sigmoidf_(x); }
__device__ __forceinline__ float lo_bf(unsigned w) { return __uint_as_float(w << 16); }
__device__ __forceinline__ float hi_bf(unsigned w) { return __uint_as_float(w & 0xffff0000u); }
__device__ __forceinline__ u32x4 pack8(const f32x4 a, const f32x4 b) { u32x4 o; o.x = cvt_pk_bf16(a[0], a[1]); o.y = cvt_pk_bf16(a[2], a[3]); o.z = cvt_pk_bf16(b[0], b[1]); o.w = cvt_pk_bf16(b[2], b[3]); return o; }
__device__ __forceinline__ int TID() { int t = threadIdx.x; asm volatile("" : "+v"(t)); return t; }
namespace pg8 {
#define PG8_LAS __attribute__((address_space(3)))
typedef unsigned short bf16_t;
typedef short bf16x8 __attribute__((ext_vector_type(8)));
typedef float f32x4 __attribute__((ext_vector_type(4)));
typedef unsigned u32x4 __attribute__((ext_vector_type(4)));
constexpr int BM = 256, BK = 64, HALF = 128, HTB = HALF * BK * 2  , STAGE_BYTES = 8 * HTB, NXCD = 8, WGM = 8;

__host__ __device__ __forceinline__ int lds_byte(int r, int c) { const int st = (r >> 4) * 2 + (c >> 5), rr = r & 15, cc = c & 31, ob = rr * 64 + cc * 2; return st * 1024 + (ob ^ (((ob >> 9) & 1) << 5)); }
__host__ __device__ __forceinline__ void stage_rc(int b, int& R, int& C) { const int st = b / 1024, sb = b % 1024, swz = sb ^ (((sb >> 9) & 1) << 5); R = (st >> 1) * 16 + swz / 64; C = (st & 1) * 32 + (swz % 64) / 2; }
__host__ __device__ __forceinline__ int perm32(int rho) { const int n = rho >> 4, i = rho & 15; return 8 * (i >> 2) + 4 * n + (i & 3); }

struct Unit { int pm, pn; };
struct Gemm { const bf16_t* A; const bf16_t* Bt; int M, N, K, lda; };
struct StaticOrder {
    int nM, nN, nwg, G, c;
    __host__ __device__ void init(int M, int N, int G_, int c_) { nM = M / BM; nN = N / BM; nwg = nM * nN; G = G_; c = c_; }
    __host__ __device__ bool next(int i, Unit& u) const {
        const long L = (long)i * G + c; if (L >= nwg) return false;
        int wgid = (int)L; { const int q = nwg / NXCD, r = nwg % NXCD, xcd = wgid % NXCD, off = wgid / NXCD; wgid = (xcd < r ? xcd * (q + 1) : r * (q + 1) + (xcd - r) * q) + off; }
        const int nig = WGM * nN, gid = wgid / nig, fm = gid * WGM, gsz = (nM - fm) < WGM ? (nM - fm) : WGM;
        u.pm = fm + ((wgid % nig) % gsz); u.pn = (wgid % nig) / gsz; return true;
    }
    __device__ __forceinline__ void a_ready(const Unit&) const {}
    __device__ __forceinline__ void done(const Unit&) const {}
};
template <class Epi, class Sched, bool STAMP = false>
__device__ __forceinline__ void gemm_phase(PG8_LAS unsigned char* lds, const Gemm g, const Sched& S, const Epi& E, unsigned long long* stamps) {
    const int tid = TID(), wid = __builtin_amdgcn_readfirstlane(tid >> 6), lane = tid & 63, wr = wid >> 2, wc = wid & 3, fr = lane & 15, fq = lane >> 4;
    const int K = g.K, nt = K / BK;
    int ts_lo = 0, ts_hi = 0, nts = 0; const unsigned long long rt_entry = STAMP ? (unsigned long long)wall_clock64() : 0ull;
#define PG8_STAMP() do { if (STAMP && wid == 0 && nts < 64) { const unsigned long long _c = (unsigned long long)clock64(); \
        ts_lo = (lane == nts) ? (int)(unsigned)_c : ts_lo; ts_hi = (lane == nts) ? (int)(unsigned)(_c >> 32) : ts_hi; ++nts; } } while (0)
    PG8_STAMP();
    unsigned voffA[2], voffB[2];
#pragma unroll
    for (int i = 0; i < 2; ++i) { int R, C; stage_rc(tid * 16 + i * 8192, R, C); const int Rb = Epi::PERM ? ((R & ~31) + perm32(R & 31)) : R;
        voffA[i] = (unsigned)(R * g.lda + C) * 2u; voffB[i] = (unsigned)(Rb * K + C) * 2u; }
    const size_t kstep = (size_t)(BK * 2);
    const size_t hstep = (size_t)HALF * K * 2, hstepA = (size_t)HALF * g.lda * 2;
    const size_t tstep = 2 * hstep, tstepA = 2 * hstepA;
    const unsigned ldsw = (unsigned)wid * 1024u;
    const int aoff = lds_byte(wr * 64 + fr, fq * 8), boff = lds_byte(wc * 32 + fr, fq * 8);
#define PG8_SA(b, h) (((b) * 2 + (h)) * HTB)
#define PG8_SB(b, h) ((4 + (b) * 2 + (h)) * HTB)
#define PG8_STAGE(bufoff, gbase, voff) do { _Pragma("unroll") for (int _i = 0; _i < 2; ++_i) \
        __builtin_amdgcn_global_load_lds((const unsigned*)((const char*)(gbase) + (voff)[_i]), (PG8_LAS unsigned*)(lds + (bufoff) + ldsw + _i * 8192), 16, 0, 0); } while (0)
#define PG8_LDA(dst, b, h) do { _Pragma("unroll") for (int m = 0; m < 4; ++m) _Pragma("unroll") for (int k = 0; k < 2; ++k) dst[m][k] = *(const PG8_LAS bf16x8*)(lds + PG8_SA(b, h) + aoff + m * 2048 + k * 1024); } while (0)
#define PG8_LDB(dst, b, h) do { _Pragma("unroll") for (int n = 0; n < 2; ++n) _Pragma("unroll") for (int k = 0; k < 2; ++k) dst[n][k] = *(const PG8_LAS bf16x8*)(lds + PG8_SB(b, h) + boff + n * 2048 + k * 1024); } while (0)
#define PG8_MMA(ai, bj, At, Bt) do { __builtin_amdgcn_s_setprio(1); _Pragma("unroll") for (int m = 0; m < 4; ++m) _Pragma("unroll") for (int n = 0; n < 2; ++n) _Pragma("unroll") for (int k = 0; k < 2; ++k) \
        acc[ai][bj][m][n] = __builtin_amdgcn_mfma_f32_16x16x32_bf16(Bt[n][k], At[m][k], acc[ai][bj][m][n], 0, 0, 0); __builtin_amdgcn_s_setprio(0); } while (0)
#define PG8_WAIT_V(n) asm volatile("s_waitcnt vmcnt(" #n ")" ::: "memory")
#define PG8_WAIT_L(n) asm volatile("s_waitcnt lgkmcnt(" #n ")" ::: "memory")
#define PG8_BAR __builtin_amdgcn_s_barrier()
#define PG8_SCHED __builtin_amdgcn_sched_barrier(0)
    Unit cur, nxt; int ui = 0;
    if (!S.next(0, cur)) return;
    f32x4 acc[2][2][4][2];
#pragma unroll
    for (int a = 0; a < 2; ++a)
#pragma unroll
        for (int b = 0; b < 2; ++b)
#pragma unroll
            for (int m = 0; m < 4; ++m)
#pragma unroll
                for (int n = 0; n < 2; ++n) acc[a][b][m][n] = (f32x4){0.f, 0.f, 0.f, 0.f};
    bf16x8 At[4][2], B0[2][2], B1[2][2];
    const char* cA = (const char*)g.A + (size_t)cur.pm * tstepA; const char* cB = (const char*)g.Bt + (size_t)cur.pn * tstep;
    S.a_ready(cur);
    PG8_STAGE(PG8_SB(0, 0), cB, voffB); PG8_STAGE(PG8_SA(0, 0), cA, voffA); PG8_STAGE(PG8_SB(0, 1), cB + hstep, voffB); PG8_STAGE(PG8_SA(0, 1), cA + hstepA, voffA);
    if (wr == 1) PG8_BAR;
    PG8_WAIT_V(4); PG8_BAR;
    PG8_STAGE(PG8_SB(1, 0), cB + kstep, voffB); PG8_STAGE(PG8_SA(1, 0), cA + kstep, voffA); PG8_STAGE(PG8_SB(1, 1), cB + hstep + kstep, voffB);
    PG8_WAIT_V(6); PG8_BAR;
    PG8_STAMP();
    for (;;) {
        const bool has_next = S.next(ui + 1, nxt);
        const char* nA = has_next ? (const char*)g.A + (size_t)nxt.pm * tstepA : cA; const char* nB = has_next ? (const char*)g.Bt + (size_t)nxt.pn * tstep : cB;
        for (int t = 0; t < nt; t += 2) {
            const bool last = (t == nt - 2);
            const char* a1 = cA + (size_t)(t + 1) * kstep;
            const char* a2 = last ? nA : cA + (size_t)(t + 2) * kstep; const char* b2 = last ? nB : cB + (size_t)(t + 2) * kstep;
            const char* a3 = a2 + kstep; const char* b3 = b2 + kstep;
            if (last && has_next) S.a_ready(nxt);
            PG8_LDB(B0, 0, 0); PG8_SCHED; PG8_LDA(At, 0, 0); PG8_STAGE(PG8_SA(1, 1), a1 + hstepA, voffA);
            PG8_WAIT_L(8); PG8_BAR; PG8_WAIT_L(0); PG8_MMA(0, 0, At, B0); PG8_BAR; PG8_SCHED;
            PG8_LDB(B1, 0, 1); PG8_STAGE(PG8_SB(0, 0), b2, voffB);
            PG8_BAR; PG8_WAIT_L(0); PG8_MMA(0, 1, At, B1); PG8_BAR;
            PG8_LDA(At, 0, 1); PG8_STAGE(PG8_SA(0, 0), a2, voffA);
            PG8_BAR; PG8_WAIT_L(0); PG8_MMA(1, 0, At, B0); PG8_BAR; PG8_SCHED;
            PG8_STAGE(PG8_SB(0, 1), b2 + hstep, voffB);
            PG8_WAIT_V(6); PG8_BAR; PG8_MMA(1, 1, At, B1); PG8_BAR;
            PG8_LDB(B0, 1, 0); PG8_SCHED; PG8_LDA(At, 1, 0); PG8_STAGE(PG8_SA(0, 1), a2 + hstepA, voffA);
            PG8_WAIT_L(8); PG8_BAR; PG8_WAIT_L(0); PG8_MMA(0, 0, At, B0); PG8_BAR; PG8_SCHED;
            PG8_LDB(B1, 1, 1); PG8_STAGE(PG8_SB(1, 0), b3, voffB);
            PG8_BAR; PG8_WAIT_L(0); PG8_MMA(0, 1, At, B1); PG8_BAR;
            PG8_LDA(At, 1, 1); PG8_STAGE(PG8_SA(1, 0), a3, voffA);
            PG8_BAR; PG8_WAIT_L(0); PG8_MMA(1, 0, At, B0); PG8_BAR; PG8_SCHED;
            PG8_STAGE(PG8_SB(1, 1), b3 + hstep, voffB);
            PG8_WAIT_V(6); PG8_BAR; PG8_MMA(1, 1, At, B1); PG8_BAR;
        }
        PG8_STAMP();
        if constexpr (!Epi::AFTER_DRAIN) { E(acc, cur, wr, wc, fr, fq); S.done(cur); }
        PG8_STAMP();
        if (!has_next) break;
#pragma unroll
        for (int a = 0; a < 2; ++a)
#pragma unroll
            for (int b = 0; b < 2; ++b)
#pragma unroll
                for (int m = 0; m < 4; ++m)
#pragma unroll
                    for (int n = 0; n < 2; ++n) acc[a][b][m][n] = (f32x4){0.f, 0.f, 0.f, 0.f};
        cur = nxt; cA = nA; cB = nB; ++ui;
    }
    PG8_WAIT_V(0);
    if (wr == 0) PG8_BAR;
    PG8_BAR;
    if constexpr (Epi::AFTER_DRAIN) { E.fused(acc, cur, wr, wc, fr, fq, lds, wid, lane); S.done(cur); }
    PG8_STAMP();
    if (STAMP && wid == 0) { stamps[lane] = lane < nts ? (((unsigned long long)(unsigned)ts_hi << 32) | (unsigned)ts_lo) : 0ull;
        if (lane == 62) stamps[62] = rt_entry; if (lane == 63) stamps[63] = (unsigned long long)wall_clock64(); }
#undef PG8_STAMP
#undef PG8_SA
#undef PG8_SB
#undef PG8_STAGE
#undef PG8_LDA
#undef PG8_LDB
#undef PG8_MMA
#undef PG8_WAIT_V
#undef PG8_WAIT_L
#undef PG8_BAR
#undef PG8_SCHED
}
}
#define XB_TMO      128
#define XB_XCNT(j)  (256  + 64 * (j))
#define XB_XSUB(j)  (1280 + 64 * (j))
#define XB_XGEN(j)  (2304 + 64 * (j))
#define XB_TOP      3328
#define XB_TOPGEN   3392
#define XCD_BAR_WORDS 3456
#define XB_SPIN_CAP (1u << 18)

__device__ __forceinline__ unsigned xb_ld(unsigned* p)              { return __hip_atomic_load(p, __ATOMIC_RELAXED, __HIP_MEMORY_SCOPE_AGENT); }
__device__ __forceinline__ unsigned xb_add(unsigned* p, unsigned v) { return __hip_atomic_fetch_add(p, v, __ATOMIC_RELAXED, __HIP_MEMORY_SCOPE_AGENT); }
__device__ __forceinline__ unsigned xb_xcc_id() { return (unsigned)__builtin_amdgcn_s_getreg((3 << 11) | 20) & 0xFu; }
#define XB_SPIN(cond, bar) do { unsigned _sp = 0; while (cond) { __builtin_amdgcn_s_sleep(1); \
    if ((++_sp & 255u) == 0u) { if (xb_ld(&(bar)[XB_TMO])) break; if (_sp > XB_SPIN_CAP) { atomicAdd(&(bar)[XB_TMO], 1u); break; } } } } while (0)

struct XcdBarrier {
    unsigned* bar; unsigned x;
    volatile LAS unsigned* st;
};

__device__ __forceinline__ XcdBarrier xcd_barrier_post(unsigned* bar, volatile LAS unsigned* st) {
    XcdBarrier b; b.bar = bar; b.x = xb_xcc_id(); b.st = st;
    if (threadIdx.x == 0) (void)xb_add(&bar[XB_XCNT(b.x)], 1u);
    return b;
}
__device__ __forceinline__ void xcd_barrier_complete(unsigned* bar, unsigned x, unsigned& nloc, unsigned& nx) {
    const unsigned G = gridDim.x * gridDim.y * gridDim.z;
    unsigned sum, cnt, mine, sp = 0u;
    for (;;) {
        sum = 0u; cnt = 0u; mine = 0u;
#pragma unroll
        for (unsigned j = 0; j < 16; ++j) { const unsigned c = xb_ld(&bar[XB_XCNT(j)]); sum += c; cnt += (c > 0u) ? 1u : 0u; mine = (j == x) ? c : mine; }
        if (sum == G) break;
        __builtin_amdgcn_s_sleep(1);
        if ((++sp & 255u) == 0u) { if (xb_ld(&bar[XB_TMO])) break; if (sp > XB_SPIN_CAP) { atomicAdd(&bar[XB_TMO], 1u); break; } }
    }
    nloc = mine > 0u ? mine : 1u; nx = cnt > 0u ? cnt : 1u;
}

__device__ __forceinline__ void xcd_barrier(const XcdBarrier& b) {
    asm volatile("s_waitcnt vmcnt(0)" ::: "memory");
    __syncthreads();
    if (threadIdx.x == 0) {
        unsigned* bar = b.bar;
        __builtin_amdgcn_s_waitcnt(0);
        unsigned nloc = b.st[0], nx = b.st[1];
        if (nloc == 0u) { xcd_barrier_complete(bar, b.x, nloc, nx); b.st[0] = nloc; b.st[1] = nx; }
        const unsigned old = xb_add(&bar[XB_XSUB(b.x)], 1u);
        const unsigned gen = old / nloc;
        if (old + 1u == (gen + 1u) * nloc) {
            __builtin_amdgcn_fence(__ATOMIC_RELEASE, "agent");
            asm volatile("s_waitcnt vmcnt(0)" ::: "memory");
            const unsigned og = xb_add(&bar[XB_TOP], 1u);
            const unsigned tg = og / nx;
            if (og + 1u == (tg + 1u) * nx) xb_add(&bar[XB_TOPGEN], 1u);
            else XB_SPIN(xb_ld(&bar[XB_TOPGEN]) == tg, bar);
            __builtin_amdgcn_fence(__ATOMIC_ACQUIRE, "agent");
            xb_add(&bar[XB_XGEN(b.x)], 1u);
            asm volatile("s_waitcnt vmcnt(0)" ::: "memory");
        } else {
            XB_SPIN(xb_ld(&bar[XB_XGEN(b.x)]) == gen, bar);
            __builtin_amdgcn_fence(__ATOMIC_ACQUIRE, "agent");
            asm volatile("s_waitcnt vmcnt(0)" ::: "memory");
        }
    }
    __syncthreads();
}

struct Params {
    const float *x_prompt, *x_sample, *state_hgrn, *cache_cmp, *cache_slc, *cache_win, *cache_mem;
    const int* page_table;
    const float *mem_prompt, *w_in, *w_out, *hg_lb, *hg_gnorm, *cmp_pe, *cmp_w1, *cmp_w2, *w_mq, *w_mkv, *w_mo, *w_up, *w_down, *ln_g, *ln_b;
    float* out;
    unsigned* bar; float *stats1, *stats2, *stats3, *cs_mq, *bw_mq, *cs_up, *bw_up, *posb;
    bf16_t *Wt_in, *Wt_out, *Wt_mq, *Wt_mkv, *Wt_mo, *Wt_up, *Wt_down, *W1t, *W2t;
    float *lbv, *rope;
    bf16_t *Xb, *Memb, *HQ, *HV, *HOG, *QN, *QR, *GA, *GB;
    float *G, *NG;
    bf16_t *CKp, *CVp, *CKs, *CVs, *SKp, *SVp, *WKp, *WVp, *SKs, *SVs, *WKs, *WVs, *MKVp;
    float *CCp, *CCs;
    bf16_t *KCp, *VCp, *KCs, *VCs;
    float *Lloc, *Dec; bf16_t* Sst;
    bf16_t *OHG, *OWIN, *OCMP, *MERGED;
    unsigned* SEL;
    float *Z1, *Z2; bf16_t *Z1b, *Z2b, *QM, *OM, *Hb;
};
__device__ __forceinline__ int ilv64(int c) { return (c & ~63) | (((c & 63) >> 1) + 32 * (c & 1)); }
__device__ __forceinline__ int win_src_col(int n) {
    const int tn = n >> 8, cl = n & 255;
    if (tn < 16) return n;
    if (tn < 20) return 4096 + (tn - 16) * 256 + ilv64(cl);
    if (tn < 26) { const int base = 5120 + (tn - 20) * 256; return base + ((tn == 22 || tn == 24) ? ilv64(cl) : cl); }
    if (tn == 26) return cl < 48 ? 6656 + cl : -1;
    if (tn < 31) return 6704 + (tn - 27) * 256 + cl;
    return 7728 + (tn - 31) * 256 + cl;
}

template <int W> __device__ __forceinline__ void transpose_tile(const Params& p, int id, int nt, int kt, LAS float* tile  ) {
    const float* src; bf16_t* dst; int K, ldsrc; const float* gain = nullptr; const float* bias = nullptr; float* cs = nullptr; float* bw = nullptr; int map = 0;
    switch (id) {
        case 0: src = p.w_in; dst = p.Wt_in; K = 1024; ldsrc = NIN; map = 1; break;
        case 1: src = p.w_out; dst = p.Wt_out; K = 1024; ldsrc = 1024; break;
        case 2: src = p.w_mq; dst = p.Wt_mq; K = 1024; ldsrc = 1024; gain = p.ln_g; bias = p.ln_b; cs = p.cs_mq; bw = p.bw_mq; break;
        case 3: src = p.w_mkv; dst = p.Wt_mkv; K = 1024; ldsrc = 2048; break;
        case 4: src = p.w_mo; dst = p.Wt_mo; K = 1024; ldsrc = 1024; break;
        case 5: src = p.w_up; dst = p.Wt_up; K = 1024; ldsrc = 4096; gain = p.ln_g + 1024; bias = p.ln_b + 1024; cs = p.cs_up; bw = p.bw_up; break;
        case 6: src = p.w_down; dst = p.Wt_down; K = 4096; ldsrc = 1024; break;
        case 7: case 8: case 9: case 10: { const int sel = (id - 7) >> 1, half = (id - 7) & 1; src = p.cmp_w1 + (size_t)(sel * 2048 + half * 1024) * 128; dst = p.W1t + (size_t)(sel * 256 + half * 128) * 1024; K = 1024; ldsrc = 128; break; }
        default: { const int sel = id - 11; src = p.cmp_w2 + (size_t)sel * 128 * 64; dst = p.W2t + (size_t)sel * 64 * 128; K = 128; ldsrc = 64; map = (sel == 0) ? 2 : 0; break; }
    }
    constexpr int NR = 64 * W / 512;
    const int t = TID(), n0 = nt * W, k0 = kt * 64;
    {
        const int nn = t & (W - 1); int sc = n0 + nn;
        if (map == 1) sc = win_src_col(sc); else if (map == 2) sc = ilv64(sc);
        float v[NR];
#pragma unroll
        for (int rr = 0; rr < NR; ++rr) { const int kk = t / W + (512 / W) * rr; v[rr] = (sc >= 0) ? src[(size_t)(k0 + kk) * ldsrc + sc] : 0.f; }
#pragma unroll
        for (int rr = 0; rr < NR; ++rr) { const int kk = t / W + (512 / W) * rr; tile[kk * (W + 1) + nn] = v[rr]; }
    }
    __syncthreads();
#pragma unroll
    for (int it = 0; it < W / 64; ++it) {
        const int c = t + 512 * it, nn = c >> 3, kc = (c & 7) * 8;
        float w[8];
#pragma unroll
        for (int j = 0; j < 8; ++j) { float x = tile[(kc + j) * (W + 1) + nn]; if (gain) x *= gain[k0 + kc + j]; w[j] = x; }
        u32x4 o; o.x = cvt_pk_bf16(w[0], w[1]); o.y = cvt_pk_bf16(w[2], w[3]); o.z = cvt_pk_bf16(w[4], w[5]); o.w = cvt_pk_bf16(w[6], w[7]);
        *(u32x4*)(dst + (size_t)(n0 + nn) * K + k0 + kc) = o;
        if (cs) {
            float s1 = lo_bf(o.x) + hi_bf(o.x) + lo_bf(o.y) + hi_bf(o.y) + lo_bf(o.z) + hi_bf(o.z) + lo_bf(o.w) + hi_bf(o.w);
            float s2 = 0.f;
#pragma unroll
            for (int j = 0; j < 8; ++j) s2 += bias[k0 + kc + j] * tile[(kc + j) * (W + 1) + nn];
            s1 += __shfl_xor(s1, 1); s1 += __shfl_xor(s1, 2); s1 += __shfl_xor(s1, 4);
            s2 += __shfl_xor(s2, 1); s2 += __shfl_xor(s2, 2); s2 += __shfl_xor(s2, 4);
            if ((t & 7) == 0) { atomicAdd(cs + n0 + nn, s1); atomicAdd(bw + n0 + nn, s2); }
        }
    }
    __syncthreads();
}

__device__ __forceinline__ void prologue_transposes2(const Params& p, LAS unsigned char* lds) {
    LAS float* tile = (LAS float*)lds;
    const int G = gridDim.x, wg = blockIdx.x;
    constexpr int NJ1 = 128, NJ2 = 128, NJ4 = 128, NJ5 = 512, NJ6 = 512, TOT = NJ1 + NJ2 + NJ4 + NJ5 + NJ6;
    for (int j = wg; j < TOT; j += G) {
        int id, r = j, nkt = 16;
        if (r < NJ1) id = 1;
        else if ((r -= NJ1) < NJ2) id = 2;
        else if ((r -= NJ2) < NJ4) id = 4;
        else if ((r -= NJ4) < NJ5) id = 5;
        else { r -= NJ5; id = 6; nkt = 64; }
        transpose_tile<128>(p, id, r / nkt, r % nkt, tile);
    }
}
__device__ __forceinline__ void phase_prologue(const Params& p, LAS unsigned char* lds) {
    LAS float* tile = (LAS float*)lds;
    const int t = TID(), G = gridDim.x, wg = blockIdx.x;
    constexpr int NJ0 = 70 * 16, NJ3 = 256, NJ7 = 32, NJ11 = 2;
    constexpr int TOT = NJ0 + NJ3 + 4 * NJ7 + 2 * NJ11;
    for (int j = wg; j < TOT; j += G) {
        int r = j;
        if (r < NJ0) transpose_tile<128>(p, 0, r / 16, r % 16, tile);
        else if ((r -= NJ0) < NJ3) transpose_tile<128>(p, 3, r / 16, r % 16, tile);
        else if ((r -= NJ3) < 4 * NJ7) { const int id = 7 + r / NJ7; r %= NJ7; transpose_tile<64>(p, id, r / 16, r % 16, tile); }
        else { r -= 4 * NJ7; const int id = 11 + r / NJ11; r %= NJ11; transpose_tile<64>(p, id, r / 2, r % 2, tile); }
    }
    prologue_transposes2(p, lds);
    {
        const size_t nx = (size_t)MT * DM / 8, nm = (size_t)NBATCH * MEMT * DM / 8, stride = (size_t)G * 512;
        for (size_t i0 = (size_t)wg * 512 + t; i0 < nx + nm; i0 += 4 * stride) {
            f32x4 a[4], b[4];
#pragma unroll
            for (int u = 0; u < 4; ++u) { const size_t i = i0 + u * stride; if (i < nx + nm) { const float* s;
                if (i < nx) { const size_t e = i * 8; s = (e < (size_t)MP * DM) ? p.x_prompt + e : p.x_sample + (e - (size_t)MP * DM); } else s = p.mem_prompt + (i - nx) * 8;
                a[u] = *(const f32x4*)s; b[u] = *(const f32x4*)(s + 4); } }
#pragma unroll
            for (int u = 0; u < 4; ++u) { const size_t i = i0 + u * stride; if (i < nx + nm) { bf16_t* d = (i < nx) ? p.Xb + i * 8 : p.Memb + (i - nx) * 8; *(u32x4*)d = pack8(a[u], b[u]); } }
        }
    }
    for (int i = wg * 512 + t; i < SEQ * 32; i += G * 512) {
        const int pos = i >> 5, fi = i & 31;
        const float inv = powf(10000.0f, -(float)fi / 32.0f);
        const float ang = (float)pos * inv;
        double rev = (double)ang * 0.15915494309189535; rev -= floor(rev);
        const float fr = (float)rev;
        p.rope[2 * i] = __builtin_amdgcn_cosf(fr); p.rope[2 * i + 1] = __builtin_amdgcn_sinf(fr);
    }
    for (int i = wg * 512 + t; i < 1024; i += G * 512) {
        const float a = p.hg_lb[i], b = p.hg_lb[1024 + i], m = fmaxf(a, b), ea = expf(a - m), eb = expf(b - m);
        p.lbv[i] = ea / (ea + eb);
    }
    for (int j = wg; j < 64; j += G) {
        const int sel = j >> 5, l = j & 31, h = t & 127, part = t >> 7;
        float s = 0.f;
        for (int d = part * 16; d < part * 16 + 16; ++d) s += p.cmp_pe[(sel * 32 + l) * 64 + d] * p.cmp_w1[((size_t)(sel * 32 + l) * 64 + d) * 128 + h];
        atomicAdd(p.posb + sel * 128 + h, s);
    }
}
#define EPI_FOR_FRAGS(...) \
    _Pragma("unroll") for (int ai = 0; ai < 2; ++ai) _Pragma("unroll") for (int m = 0; m < 4; ++m) _Pragma("unroll") for (int bj = 0; bj < 2; ++bj) { \
        const int row = u.pm * 256 + ai * 128 + wr * 64 + m * 16 + fr, cl = bj * 128 + wc * 32 + 8 * fq; \
        const f32x4 v0 = acc[ai][bj][m][0], v1 = acc[ai][bj][m][1]; (void)row; (void)cl; __VA_ARGS__ }


struct Epi1 {
    static constexpr bool PERM = true, AFTER_DRAIN = false;
    const Params* pp;
    __device__ __forceinline__ void operator()(const f32x4 (&acc)[2][2][4][2], const pg8::Unit& u, int wr, int wc, int fr, int fq) const {
        const Params& p = *pp;
        const int pn = u.pn;
        const float* __restrict__ ropeT = p.rope; const float* __restrict__ lbT = p.lbv;
        if (pn < 4 || (pn >= 12 && pn < 16)) {
            bf16_t* dst = (pn < 4) ? p.HQ + pn * 256 : p.HOG + (pn - 12) * 256;
            EPI_FOR_FRAGS({ f32x4 a, b; for (int j = 0; j < 4; ++j) { a[j] = siluf_(v0[j]); b[j] = siluf_(v1[j]); } *(u32x4*)(dst + (size_t)row * 1024 + cl) = pack8(a, b); })
        } else if (pn < 8) {
            const int c0 = (pn - 4) * 256;
            EPI_FOR_FRAGS({ const f32x4 l0 = *(const f32x4*)(lbT + c0 + cl), l1 = *(const f32x4*)(lbT + c0 + cl + 4); f32x4 a, b;
                for (int j = 0; j < 4; ++j) { a[j] = __logf(l0[j] + (1.f - l0[j]) * sigmoidf_(v0[j])); b[j] = __logf(l1[j] + (1.f - l1[j]) * sigmoidf_(v1[j])); }
                float* d = p.G + (size_t)row * 1024 + c0 + cl; *(f32x4*)d = a; *(f32x4*)(d + 4) = b; })
        } else if (pn < 12) {
            bf16_t* dst = p.HV + (pn - 8) * 256;
            EPI_FOR_FRAGS({ *(u32x4*)(dst + (size_t)row * 1024 + cl) = pack8(v0, v1); })
        } else if (pn < 20) {
            const int c0 = (pn - 16) * 256;
            EPI_FOR_FRAGS({ const int pos = row < MP ? (row & (SEQ - 1)) : PAST + ((row - MP) & 7);
                const f32x4 r0 = *(const f32x4*)(ropeT + ((size_t)pos * 32 + ((cl & 63) >> 1)) * 2), r1 = *(const f32x4*)(ropeT + ((size_t)pos * 32 + ((cl & 63) >> 1)) * 2 + 4);
                *(u32x4*)(p.QN + (size_t)row * 1024 + c0 + cl) = pack8(v0, v1);
                f32x4 a, b;
                a[0] = v0[0] * r0[0] - v0[1] * r0[1]; a[1] = v0[1] * r0[0] + v0[0] * r0[1]; a[2] = v0[2] * r0[2] - v0[3] * r0[3]; a[3] = v0[3] * r0[2] + v0[2] * r0[3];
                b[0] = v1[0] * r1[0] - v1[1] * r1[1]; b[1] = v1[1] * r1[0] + v1[0] * r1[1]; b[2] = v1[2] * r1[2] - v1[3] * r1[3]; b[3] = v1[3] * r1[2] + v1[2] * r1[3];
                *(u32x4*)(p.QR + (size_t)row * 1024 + c0 + cl) = pack8(a, b); })
        } else if (pn < 26) {
            const int br = (pn - 20) >> 1, sel = (pn - 20) & 1;
            EPI_FOR_FRAGS({
                const bool isp = row < MP; const int rs = row - MP, b = isp ? (row >> 13) : (rs >> 3), tt = isp ? (row & (SEQ - 1)) : (rs & 7);
                const int kv = cl >> 6, c6 = cl & 63;
                float* o = nullptr;
                if (br == 0) o = isp ? p.out + OFF_PCMP + (size_t)row * 512 : p.out + OFF_SCMP + (size_t)rs * 512;
                else if (br == 1) o = isp ? p.out + OFF_PSLC + (size_t)row * 512 : p.out + OFF_SSLC + (size_t)rs * 512;
                else { if (isp) { if (tt >= SEQ - WIN) o = p.out + OFF_PWIN + (size_t)(b * WIN + tt - (SEQ - WIN)) * 512; } else o = p.out + OFF_SWIN + (size_t)(b * WIN + (WIN - DSEQ) + tt) * 512; }
                bf16_t* cp;
                if (br == 0) cp = isp ? (sel ? p.CVp : p.CKp) + ((size_t)kv * MP + row) * 64 : nullptr;
                else if (br == 1) cp = isp ? (sel ? p.SVp : p.SKp) + ((size_t)kv * MP + row) * 64 : (sel ? p.SVs : p.SKs) + ((size_t)kv * MS + rs) * 64;
                else cp = isp ? (sel ? p.WVp : p.WKp) + ((size_t)kv * MP + row) * 64 : (sel ? p.WVs : p.WKs) + ((size_t)kv * MS + rs) * 64;
                if (sel == 1 || br == 0) {
                    if (o) { float* d = o + sel * 256 + cl; *(f32x4*)d = v0; *(f32x4*)(d + 4) = v1; }
                    if (cp) *(u32x4*)(cp + c6) = pack8(v0, v1);
                } else {
                    const int pos = isp ? tt : PAST + tt, i0 = c6 >> 1;
                    const f32x4 r0 = *(const f32x4*)(ropeT + ((size_t)pos * 32 + i0) * 2), r1 = *(const f32x4*)(ropeT + ((size_t)pos * 32 + i0) * 2 + 4);
                    f32x4 lo, hi;
                    lo[0] = v0[0] * r0[0] - v0[1] * r0[1]; hi[0] = v0[1] * r0[0] + v0[0] * r0[1]; lo[1] = v0[2] * r0[2] - v0[3] * r0[3]; hi[1] = v0[3] * r0[2] + v0[2] * r0[3];
                    lo[2] = v1[0] * r1[0] - v1[1] * r1[1]; hi[2] = v1[1] * r1[0] + v1[0] * r1[1]; lo[3] = v1[2] * r1[2] - v1[3] * r1[3]; hi[3] = v1[3] * r1[2] + v1[2] * r1[3];
                    if (o) { float* d = o + kv * 64 + i0; *(f32x4*)d = lo; *(f32x4*)(d + 32) = hi; }
                    if (cp) { u32x4 w; w.x = cvt_pk_bf16(lo[0], hi[0]); w.y = cvt_pk_bf16(lo[1], hi[1]); w.z = cvt_pk_bf16(lo[2], hi[2]); w.w = cvt_pk_bf16(lo[3], hi[3]); *(u32x4*)(cp + c6) = w; }
                } })
        } else if (pn == 26) {
            EPI_FOR_FRAGS({ if (cl < 48) { f32x4 a, b; for (int j = 0; j < 4; ++j) { a[j] = sigmoidf_(v0[j]); b[j] = sigmoidf_(v1[j]); } float* d = p.NG + (size_t)row * 48 + cl; *(f32x4*)d = a; *(f32x4*)(d + 4) = b; } })
        } else {
            bf16_t* dst = (pn < 31) ? p.GA + (pn - 27) * 256 : p.GB + (pn - 31) * 256;
            EPI_FOR_FRAGS({ f32x4 a, b; for (int j = 0; j < 4; ++j) { a[j] = sigmoidf_(v0[j]); b[j] = sigmoidf_(v1[j]); } *(u32x4*)(dst + (size_t)row * 1024 + cl) = pack8(a, b); })
        }
    }
};

struct EpiPlain {
    static constexpr bool PERM = true, AFTER_DRAIN = false;
    float* C; int ldc; bf16_t* Cb; int ldb;
    __device__ __forceinline__ void operator()(const f32x4 (&acc)[2][2][4][2], const pg8::Unit& u, int wr, int wc, int fr, int fq) const {
        EPI_FOR_FRAGS({ const int col = u.pn * 256 + cl;
            if (C) { float* d = C + (size_t)row * ldc + col; *(f32x4*)d = v0; *(f32x4*)(d + 4) = v1; }
            if (Cb) *(u32x4*)(Cb + (size_t)row * ldb + col) = pack8(v0, v1); })
    }
    __device__ __forceinline__ void small(int row, int col, const f32x4 a0, const f32x4 a1, int) const {
        if (C) { float* d = C + (size_t)row * ldc + col; *(f32x4*)d = a0; *(f32x4*)(d + 4) = a1; }
        if (Cb) *(u32x4*)(Cb + (size_t)row * ldb + col) = pack8(a0, a1);
    }
};

struct G1Order {
    pg8::StaticOrder so; int G, c;
    __device__ void init(int G_, int c_) { G = G_; c = c_; so.init(MP, 34 * 256, G_, c_); }
    __device__ bool next(int i, pg8::Unit& u) const {
        const int L = i * G + c;
        if (L < 64 * 34) { if (!so.next(i, u)) return false; u.pn = u.pn < 26 ? u.pn : u.pn + 1; return true; }
        const int L2 = L - 64 * 34; if (L2 >= 128) return false;
        u.pm = 64 + (L2 & 3); const int q = L2 >> 2; u.pn = q < 26 ? q : q + 1; return true;
    }
    __device__ __forceinline__ void a_ready(const pg8::Unit&) const {}
    __device__ __forceinline__ void done(const pg8::Unit&) const {}
};
struct Epi1Small {
    int kind; const Params* pp;
    __device__ __forceinline__ void small(int row, int col, const f32x4 a0, const f32x4 a1, int) const {
        const Params& p = *pp; f32x4 a, b;
#pragma unroll
        for (int j = 0; j < 4; ++j) { a[j] = sigmoidf_(a0[j]); b[j] = sigmoidf_(a1[j]); }
        if (kind == 0) { if (col < 48) { float* d = p.NG + (size_t)row * 48 + col; *(f32x4*)d = a; *(f32x4*)(d + 4) = b; } }
        else *(u32x4*)(p.GB + (size_t)row * 1024 + 512 + col) = pack8(a, b);
    }
};
__device__ __forceinline__ void phase_gemm1(const Params& p, LAS unsigned char* lds) {
    pg8::Gemm g{p.Xb, p.Wt_in, MT, NINP, DM, DM};
    G1Order S; S.init(gridDim.x, blockIdx.x);
    Epi1 E{&p};
    pg8::gemm_phase<Epi1, G1Order, false>(lds, g, S, E, nullptr);
}
template <int HD> __device__ __forceinline__ int ktile_byte(int key, int d) { const int st = (key >> 4) * (HD / 32) + (d >> 5), ob = (key & 15) * 64 + (d & 31) * 2; return st * 1024 + (ob ^ (((ob >> 9) & 1) << 5)); }
template <int HD> constexpr int vstride() { return HD * 2 + 32; }
template <int HD> constexpr int ktile_bytes() { return 64 * HD * 2; }
template <int HD> constexpr int vtile_bytes() { return 64 * vstride<HD>(); }
typedef short s16x4 __attribute__((ext_vector_type(4)));
constexpr float NEG_INF = -__builtin_huge_valf();

template <int HD> struct AttnTile {
    bf16x8 q[HD / 32];
    f32x4 o[HD / 16];
    float m, l;
    __device__ __forceinline__ void init() { m = NEG_INF; l = 0.f;
#pragma unroll
        for (int i = 0; i < HD / 16; ++i) o[i] = (f32x4){0.f, 0.f, 0.f, 0.f}; }
};

__device__ __forceinline__ bf16x8 ldq_scaled(const bf16_t* q, float c) {
    const u32x4 v = *(const u32x4*)q; u32x4 o;
    o.x = cvt_pk_bf16(lo_bf(v.x) * c, hi_bf(v.x) * c); o.y = cvt_pk_bf16(lo_bf(v.y) * c, hi_bf(v.y) * c); o.z = cvt_pk_bf16(lo_bf(v.z) * c, hi_bf(v.z) * c); o.w = cvt_pk_bf16(lo_bf(v.w) * c, hi_bf(v.w) * c);
    return __builtin_bit_cast(bf16x8, o);
}
template <int HD, int NT> __device__ __forceinline__ void attn_scores(f32x4 (&s)[NT][4], AttnTile<HD>* const (&T)[NT], const LAS unsigned char* Kt, int lane) {
    const int fr = lane & 15, g = lane >> 4;
#pragma unroll
    for (int kt = 0; kt < 4; ++kt) {
        bf16x8 kf[HD / 32];
#pragma unroll
        for (int ds = 0; ds < HD / 32; ++ds) kf[ds] = *(const LAS bf16x8*)(Kt + ktile_byte<HD>(16 * kt + fr, 32 * ds + 8 * g));
#pragma unroll
        for (int u = 0; u < NT; ++u) { f32x4 acc = (f32x4){0.f, 0.f, 0.f, 0.f};
#pragma unroll
            for (int ds = 0; ds < HD / 32; ++ds) acc = __builtin_amdgcn_mfma_f32_16x16x32_bf16(kf[ds], T[u]->q[ds], acc, 0, 0, 0);
            s[u][kt] = acc; }
    }
}
template <int HD, int NT> __device__ __forceinline__ void attn_pv(AttnTile<HD>* const (&T)[NT], const bf16x8 (&pf)[NT][2], const LAS unsigned char* Vt, int lane) {
    const int fr = lane & 15, g = lane >> 4;
    const LAS unsigned char* vb = Vt + (4 * g + (fr >> 2)) * vstride<HD>() + (fr & 3) * 8;
#pragma unroll
    for (int dt = 0; dt < HD / 16; ++dt) {
        bf16x8 vf[2];
#pragma unroll
        for (int ph = 0; ph < 2; ++ph) {
            const s16x4 a = __builtin_amdgcn_ds_read_tr16_b64_v4i16((LAS s16x4*)(vb + (32 * ph) * vstride<HD>() + dt * 32));
            const s16x4 b = __builtin_amdgcn_ds_read_tr16_b64_v4i16((LAS s16x4*)(vb + (32 * ph + 16) * vstride<HD>() + dt * 32));
            vf[ph] = (bf16x8){a[0], a[1], a[2], a[3], b[0], b[1], b[2], b[3]};
        }
#pragma unroll
        for (int u = 0; u < NT; ++u)
#pragma unroll
            for (int ph = 0; ph < 2; ++ph) T[u]->o[dt] = __builtin_amdgcn_mfma_f32_16x16x32_bf16(vf[ph], pf[u][ph], T[u]->o[dt], 0, 0, 0);
    }
}
__device__ __forceinline__ float xmax16_32(float v) {
    auto r = __builtin_amdgcn_permlane32_swap(__float_as_uint(v), __float_as_uint(v), false, false); v = fmaxf(__uint_as_float(r[0]), __uint_as_float(r[1]));
    auto q = __builtin_amdgcn_permlane16_swap(__float_as_uint(v), __float_as_uint(v), false, false); return fmaxf(__uint_as_float(q[0]), __uint_as_float(q[1]));
}
__device__ __forceinline__ float xsum16_32(float v) {
    auto r = __builtin_amdgcn_permlane32_swap(__float_as_uint(v), __float_as_uint(v), false, false); v = __uint_as_float(r[0]) + __uint_as_float(r[1]);
    auto q = __builtin_amdgcn_permlane16_swap(__float_as_uint(v), __float_as_uint(v), false, false); return __uint_as_float(q[0]) + __uint_as_float(q[1]);
}

template <int HD, int NT, bool UM, class RowF, class MaskF>
__device__ __forceinline__ void attn_block(AttnTile<HD>* const (&T)[NT], const LAS unsigned char* Kt, const LAS unsigned char* Vt, float c, RowF&& rowok, MaskF&& mask, int lane) {
    const int g = lane >> 4;
    f32x4 s[NT][4];
    attn_scores<HD, NT>(s, T, Kt, lane);
    bf16x8 pf[NT][2];
#pragma unroll
    for (int u = 0; u < NT; ++u) {
        if (UM) {
#pragma unroll
            for (int kt = 0; kt < 4; ++kt)
#pragma unroll
                for (int r = 0; r < 4; ++r) s[u][kt][r] = mask(u, 16 * kt + 4 * g + r) ? s[u][kt][r] : NEG_INF;
        }
        const bool ok = rowok(u);
        float mx = fmaxf(fmaxf(fmaxf(s[u][0][0], s[u][0][1]), fmaxf(s[u][0][2], s[u][0][3])), fmaxf(fmaxf(s[u][1][0], s[u][1][1]), fmaxf(s[u][1][2], s[u][1][3])));
        mx = fmaxf(mx, fmaxf(fmaxf(fmaxf(s[u][2][0], s[u][2][1]), fmaxf(s[u][2][2], s[u][2][3])), fmaxf(fmaxf(s[u][3][0], s[u][3][1]), fmaxf(s[u][3][2], s[u][3][3]))));
        mx = xmax16_32(ok ? mx : NEG_INF);
        const float mnew = fmaxf(T[u]->m, mx), msafe = (mnew == NEG_INF) ? 0.f : mnew;
        const float alpha = __builtin_amdgcn_exp2f(T[u]->m - msafe), mc = ok ? msafe : 3.0e38f;
        f32x4 ps4 = (f32x4){0.f, 0.f, 0.f, 0.f};
#pragma unroll
        for (int kt = 0; kt < 4; ++kt) { const f32x4 t = s[u][kt] - mc; f32x4 e; e[0] = __builtin_amdgcn_exp2f(t[0]); e[1] = __builtin_amdgcn_exp2f(t[1]); e[2] = __builtin_amdgcn_exp2f(t[2]); e[3] = __builtin_amdgcn_exp2f(t[3]); s[u][kt] = e; ps4 += e; }
        T[u]->l = T[u]->l * alpha + ((ps4[0] + ps4[1]) + (ps4[2] + ps4[3])); T[u]->m = mnew;
#pragma unroll
        for (int dt = 0; dt < HD / 16; ++dt) T[u]->o[dt] *= alpha;
#pragma unroll
        for (int ph = 0; ph < 2; ++ph) {
            u32x4 w; w.x = cvt_pk_bf16(s[u][2 * ph][0], s[u][2 * ph][1]); w.y = cvt_pk_bf16(s[u][2 * ph][2], s[u][2 * ph][3]);
            w.z = cvt_pk_bf16(s[u][2 * ph + 1][0], s[u][2 * ph + 1][1]); w.w = cvt_pk_bf16(s[u][2 * ph + 1][2], s[u][2 * ph + 1][3]);
            pf[u][ph] = __builtin_bit_cast(bf16x8, w);
        }
    }
    attn_pv<HD, NT>(T, pf, Vt, lane);
}
template <int HD, class MaskF> __device__ __forceinline__ void attn_block2(AttnTile<HD> (&T)[2], const LAS unsigned char* Kt, const LAS unsigned char* Vt, float c, bool use_mask, MaskF&& mask, int lane) {
    AttnTile<HD>* const tp[2] = {&T[0], &T[1]};
    if (use_mask) attn_block<HD, 2, true>(tp, Kt, Vt, c, [](int) { return true; }, mask, lane); else attn_block<HD, 2, false>(tp, Kt, Vt, c, [](int) { return true; }, mask, lane);
}
template <int HD, class MaskF> __device__ __forceinline__ void attn_block1(AttnTile<HD>& T, int u0, const LAS unsigned char* Kt, const LAS unsigned char* Vt, float c, bool use_mask, MaskF&& mask, int lane) {
    AttnTile<HD>* const tp[1] = {&T};
    if (use_mask) attn_block<HD, 1, true>(tp, Kt, Vt, c, [](int) { return true; }, [&](int, int kl) { return mask(u0, kl); }, lane); else attn_block<HD, 1, false>(tp, Kt, Vt, c, [](int) { return true; }, [&](int, int kl) { return mask(u0, kl); }, lane);
}
template <bool UM, class RowF, class MaskF> __device__ __forceinline__ void attn_block_sel_um(AttnTile<64> (&T)[2], bool a0, bool a1, const LAS unsigned char* Kt, const LAS unsigned char* Vt, float c, RowF&& rowok, MaskF&& mask, int lane) {
    if (a0 && a1) { AttnTile<64>* const tp[2] = {&T[0], &T[1]}; attn_block<64, 2, UM>(tp, Kt, Vt, c, rowok, mask, lane); }
    else if (a0) { AttnTile<64>* const tp[1] = {&T[0]}; attn_block<64, 1, UM>(tp, Kt, Vt, c, [&](int) { return rowok(0); }, [&](int, int kl) { return mask(0, kl); }, lane); }
    else if (a1) { AttnTile<64>* const tp[1] = {&T[1]}; attn_block<64, 1, UM>(tp, Kt, Vt, c, [&](int) { return rowok(1); }, [&](int, int kl) { return mask(1, kl); }, lane); }
}
template <class RowF, class MaskF> __device__ __forceinline__ void attn_block_sel(AttnTile<64> (&T)[2], bool a0, bool a1, const LAS unsigned char* Kt, const LAS unsigned char* Vt, float c, RowF&& rowok, bool use_mask, MaskF&& mask, int lane) {
    if (use_mask) attn_block_sel_um<true>(T, a0, a1, Kt, Vt, c, rowok, mask, lane); else attn_block_sel_um<false>(T, a0, a1, Kt, Vt, c, rowok, mask, lane);
}

__device__ __forceinline__ void stage_k64_bf16(LAS unsigned char* Kt, const bf16_t* src, int nvalid) {
    const int t = TID(), key = t >> 3, ch = t & 7;
    u32x4 v = (u32x4){0u, 0u, 0u, 0u}; if (key < nvalid) v = *(const u32x4*)(src + (size_t)key * 64 + ch * 8);
    *(LAS u32x4*)(Kt + ktile_byte<64>(key, ch * 8)) = v;
}
__device__ __forceinline__ void stage_v64_bf16(LAS unsigned char* Vt, const bf16_t* src, int nvalid) {
    const int t = TID(), key = t >> 3, ch = t & 7;
    u32x4 v = (u32x4){0u, 0u, 0u, 0u}; if (key < nvalid) v = *(const u32x4*)(src + (size_t)key * 64 + ch * 8);
    *(LAS u32x4*)(Vt + key * vstride<64>() + ch * 16) = v;
}
__device__ __forceinline__ void stage_k64_f32(LAS unsigned char* Kt, const float* src, size_t row_stride, int nvalid, float* copy, size_t copy_stride, int copy_from) {
    const int t = TID(), key = t >> 3, ch = t & 7;
    u32x4 v = (u32x4){0u, 0u, 0u, 0u};
    if (key < nvalid) { const float* s = src + (size_t)key * row_stride + ch * 4; const f32x4 a = *(const f32x4*)s, b = *(const f32x4*)(s + 32);
        v.x = cvt_pk_bf16(a[0], b[0]); v.y = cvt_pk_bf16(a[1], b[1]); v.z = cvt_pk_bf16(a[2], b[2]); v.w = cvt_pk_bf16(a[3], b[3]);
        if (copy && key >= copy_from) { float* d = copy + (size_t)key * copy_stride + ch * 4; *(f32x4*)d = a; *(f32x4*)(d + 32) = b; } }
    *(LAS u32x4*)(Kt + ktile_byte<64>(key, ch * 8)) = v;
}
__device__ __forceinline__ void stage_v64_f32(LAS unsigned char* Vt, const float* src, size_t row_stride, int nvalid, float* copy, size_t copy_stride, int copy_from) {
    const int t = TID(), key = t >> 3, ch = t & 7;
    u32x4 v = (u32x4){0u, 0u, 0u, 0u};
    if (key < nvalid) { const float* s = src + (size_t)key * row_stride + ch * 8; const f32x4 a = *(const f32x4*)s, b = *(const f32x4*)(s + 4);
        v = pack8(a, b);
        if (copy && key >= copy_from) { float* d = copy + (size_t)key * copy_stride + ch * 8; *(f32x4*)d = a; *(f32x4*)(d + 4) = b; } }
    *(LAS u32x4*)(Vt + key * vstride<64>() + ch * 16) = v;
}

__device__ __forceinline__ u32x4 ld_bf16_item(const bf16_t* src, int item, int nvalid) { const int key = item >> 3, ch = item & 7; return key < nvalid ? *(const u32x4*)(src + (size_t)key * 64 + ch * 8) : (u32x4){0u, 0u, 0u, 0u}; }
__device__ __forceinline__ void st_k_item(LAS unsigned char* Kt, int item, u32x4 v) { *(LAS u32x4*)(Kt + ktile_byte<64>(item >> 3, (item & 7) * 8)) = v; }
__device__ __forceinline__ void st_v_item(LAS unsigned char* Vt, int item, u32x4 v) { *(LAS u32x4*)(Vt + (item >> 3) * vstride<64>() + (item & 7) * 16) = v; }
__device__ __forceinline__ void stage_kv_f32_block(const float* __restrict__ src, size_t row_stride, int lane, LAS unsigned char* Kt, LAS unsigned char* Vt, float* __restrict__ copy, size_t copy_stride, int copy_from) {
    f32x4 ka[8], kb[8], va[8], vb[8];
#pragma unroll
    for (int i = 0; i < 8; ++i) { const int item = lane + 64 * i, key = item >> 3, ch = item & 7; const float* s = src + (size_t)key * row_stride + ch * 4; ka[i] = *(const f32x4*)s; kb[i] = *(const f32x4*)(s + 32); }
#pragma unroll
    for (int i = 0; i < 8; ++i) { const int item = lane + 64 * i, key = item >> 3, ch = item & 7; const float* s = src + 256 + (size_t)key * row_stride + ch * 8; va[i] = *(const f32x4*)s; vb[i] = *(const f32x4*)(s + 4); }
#pragma unroll
    for (int i = 0; i < 8; ++i) { const int item = lane + 64 * i, key = item >> 3, ch = item & 7;
        if (copy && key >= copy_from) { float* d = copy + (size_t)key * copy_stride + ch * 4; *(f32x4*)d = ka[i]; *(f32x4*)(d + 32) = kb[i]; }
        u32x4 v; v.x = cvt_pk_bf16(ka[i][0], kb[i][0]); v.y = cvt_pk_bf16(ka[i][1], kb[i][1]); v.z = cvt_pk_bf16(ka[i][2], kb[i][2]); v.w = cvt_pk_bf16(ka[i][3], kb[i][3]); st_k_item(Kt, item, v); }
#pragma unroll
    for (int i = 0; i < 8; ++i) { const int item = lane + 64 * i, key = item >> 3, ch = item & 7;
        if (copy && key >= copy_from) { float* d = copy + 256 + (size_t)key * copy_stride + ch * 8; *(f32x4*)d = va[i]; *(f32x4*)(d + 4) = vb[i]; }
        st_v_item(Vt, item, pack8(va[i], vb[i])); }
}

constexpr float ATT_C = 0.125f * 1.44269504088896f;
constexpr int L_KT = 1024, L_VT = L_KT + 4 * 8192, L_BQ = L_VT + 4 * 10240, L_BE = L_BQ + 32768, L_MISC = L_BE + 32768;

template <int HD> __device__ __forceinline__ void attn_store_bf16(const AttnTile<HD>& T, bf16_t* dst, int lane) {
    const int g = lane >> 4; const float inv = 1.0f / fmaxf(xsum16_32(T.l), 1e-30f);
#pragma unroll
    for (int dt = 0; dt < HD / 16; ++dt) { u32x2 w; w.x = cvt_pk_bf16(T.o[dt][0] * inv, T.o[dt][1] * inv); w.y = cvt_pk_bf16(T.o[dt][2] * inv, T.o[dt][3] * inv); *(u32x2*)(dst + 16 * dt + 4 * g) = w; }
}

__device__ __forceinline__ unsigned fkey(float f) { const unsigned b = __float_as_uint(f); return b ^ ((b >> 31) ? 0xffffffffu : 0x80000000u); }
__device__ __forceinline__ int dpp_xor1(int v) { return __builtin_amdgcn_update_dpp(v, v, 0xB1, 0xF, 0xF, false); }
__device__ __forceinline__ int dpp_xor2(int v) { return __builtin_amdgcn_update_dpp(v, v, 0x4E, 0xF, 0xF, false); }
__device__ __forceinline__ int dpp_hmirror(int v) { return __builtin_amdgcn_update_dpp(v, v, 0x141, 0xF, 0xF, false); }
__device__ __forceinline__ float qsum4(float v) { v += __int_as_float(dpp_xor1(__float_as_int(v))); v += __int_as_float(dpp_xor2(__float_as_int(v))); return v; }
__device__ __forceinline__ int gsum8(int v) { v += dpp_xor1(v); v += dpp_xor2(v); v += dpp_hmirror(v); return v; }

constexpr int C_KT = 1024, C_VT = C_KT + 8 * 8192, C_SC = C_VT + 4 * 10240, C_END = C_SC + 64 * 128 * 4;
static_assert(C_END <= 160 * 1024 - 64, "cmp LDS map");
__device__ __forceinline__ void cmp_unit(const Params& p, bool sample, int unit, LAS unsigned char* lds) {
    constexpr float QSC = 1.0f;
    const int tid = TID(), lane = tid & 63, w = tid >> 6, fr = lane & 15, g = lane >> 4;
    int b, kv, qt, t0, nkeys_tot; size_t row0; const bf16_t *KC, *VC;
    if (!sample) { b = unit >> 9; kv = (unit >> 7) & 3; qt = unit & 127; t0 = qt * 64; row0 = (size_t)b * SEQ + t0; nkeys_tot = NCMP_P;
        KC = p.KCp + (size_t)(b * 4 + kv) * 512 * 64; VC = p.VCp + (size_t)(b * 4 + kv) * 512 * 64; }
    else { b = unit >> 2; kv = unit & 3; qt = PAST / 64; t0 = PAST; row0 = (size_t)MP + b * 8; nkeys_tot = NCMP_S;
        KC = p.KCs + (size_t)(b * 4 + kv) * 128 * 64; VC = p.VCs + (size_t)(b * 4 + kv) * 128 * 64; }
    const bool wact = !sample || w == 0;
    const int tmax = sample ? PAST + 7 : t0 + 63;
    int nv = tmax >= 31 ? (tmax - 31) / 16 + 1 : 0; if (nv > nkeys_tot) nv = nkeys_tot;
    const int nblk = (nv + 63) >> 6;
    AttnTile<64> T[2]; AttnTile<64>* const tp[2] = {&T[0], &T[1]};
    int qpos[2];
#pragma unroll
    for (int u = 0; u < 2; ++u) { T[u].init(); const int tl = 8 * w + 4 * u + (fr >> 2); qpos[u] = t0 + (sample ? (tl & 7) : tl); const size_t row = row0 + (sample ? (tl & 7) : tl);
        const bf16_t* q = p.QN + row * 1024 + (kv * 4 + (fr & 3)) * 64 + 8 * g; T[u].q[0] = ldq_scaled(q, QSC); T[u].q[1] = ldq_scaled(q + 32, QSC); }
    LAS unsigned char* Kt = lds + C_KT; LAS unsigned char* Vt = lds + C_VT;
    LAS float* SC = (LAS float*)(lds + C_SC);
    __syncthreads();
    for (int i = tid; i < 64 * 128; i += 512) SC[i] = 0.f;
    {
        u32x4 rk[8], rv[4];
#pragma unroll
        for (int kb = 0; kb < 8; ++kb) if (kb < nblk) rk[kb] = ld_bf16_item(KC + (size_t)kb * 4096, tid, nv - kb * 64);
#pragma unroll
        for (int kb = 0; kb < 4; ++kb) if (kb < nblk) rv[kb] = ld_bf16_item(VC + (size_t)kb * 4096, tid, nv - kb * 64);
#pragma unroll
        for (int kb = 0; kb < 8; ++kb) if (kb < nblk) st_k_item(Kt + kb * 8192, tid, rk[kb]);
#pragma unroll
        for (int kb = 0; kb < 4; ++kb) if (kb < nblk) st_v_item(Vt + kb * 10240, tid, rv[kb]);
    }
    __syncthreads();
    if (wact) for (int kb = 0; kb < nblk; ++kb) {
        f32x4 s[2][4]; attn_scores<64, 2>(s, tp, Kt + kb * 8192, lane);
#pragma unroll
        for (int u = 0; u < 2; ++u) {
            float mx = NEG_INF;
#pragma unroll
            for (int kt = 0; kt < 4; ++kt)
#pragma unroll
                for (int r = 0; r < 4; ++r) { const int n = kb * 64 + 16 * kt + 4 * g + r; if (16 * n + 31 > qpos[u] || n >= nv) s[u][kt][r] = NEG_INF; mx = fmaxf(mx, s[u][kt][r]); }
            mx = xmax16_32(mx);
            const float mnew = fmaxf(T[u].m, mx), msafe = (mnew == NEG_INF) ? 0.f : mnew, alpha = __builtin_amdgcn_exp2f((T[u].m - msafe) * ATT_C), mc = msafe * ATT_C;
            float ps = 0.f;
#pragma unroll
            for (int kt = 0; kt < 4; ++kt)
#pragma unroll
                for (int r = 0; r < 4; ++r) ps += __builtin_amdgcn_exp2f(s[u][kt][r] * ATT_C - mc);
            T[u].l = T[u].l * alpha + ps; T[u].m = mnew;
        }
    }
    float mfin[2], linv[2];
#pragma unroll
    for (int u = 0; u < 2; ++u) { const float lt = xsum16_32(T[u].l); linv[u] = 1.0f / fmaxf(lt, 1e-30f); mfin[u] = ((T[u].m == NEG_INF) ? 0.f : T[u].m) * ATT_C; }
    for (int kb = 0; kb < nblk; ++kb) {
        if (kb == 4) { __syncthreads();
            { u32x4 rv[4];
#pragma unroll
                for (int k2 = 4; k2 < 8; ++k2) if (k2 < nblk) rv[k2 - 4] = ld_bf16_item(VC + (size_t)k2 * 4096, tid, nv - k2 * 64);
#pragma unroll
                for (int k2 = 4; k2 < 8; ++k2) if (k2 < nblk) st_v_item(Vt + (k2 - 4) * 10240, tid, rv[k2 - 4]); }
            __syncthreads(); }
        if (wact) {
            f32x4 s[2][4]; attn_scores<64, 2>(s, tp, Kt + kb * 8192, lane);
            bf16x8 pf[2][2];
#pragma unroll
            for (int u = 0; u < 2; ++u) {
#pragma unroll
                for (int kt = 0; kt < 4; ++kt) {
                    float qs = 0.f;
#pragma unroll
                    for (int r = 0; r < 4; ++r) { const int n = kb * 64 + 16 * kt + 4 * g + r; const bool ok = (16 * n + 31 <= qpos[u]) && n < nv;
                        const float e = ok ? __builtin_amdgcn_exp2f(s[u][kt][r] * ATT_C - mfin[u]) * linv[u] : 0.f; s[u][kt][r] = e; qs += e; }
                    float es = s[u][kt][3];
                    qs = qsum4(qs); es = qsum4(es);
                    if ((fr & 3) == 0) { const int tl = (sample ? 0 : 8 * w) + 4 * u + (fr >> 2), jq = kb * 16 + 4 * kt + g;
                        __hip_atomic_fetch_add(SC + tl * 128 + jq, qs, __ATOMIC_RELAXED, __HIP_MEMORY_SCOPE_WORKGROUP); if (jq < 127) __hip_atomic_fetch_add(SC + tl * 128 + jq + 1, es, __ATOMIC_RELAXED, __HIP_MEMORY_SCOPE_WORKGROUP); }
                }
#pragma unroll
                for (int ph = 0; ph < 2; ++ph) {
                    u32x4 wv; wv.x = cvt_pk_bf16(s[u][2 * ph][0], s[u][2 * ph][1]); wv.y = cvt_pk_bf16(s[u][2 * ph][2], s[u][2 * ph][3]);
                    wv.z = cvt_pk_bf16(s[u][2 * ph + 1][0], s[u][2 * ph + 1][1]); wv.w = cvt_pk_bf16(s[u][2 * ph + 1][2], s[u][2 * ph + 1][3]);
                    pf[u][ph] = __builtin_bit_cast(bf16x8, wv);
                }
            }
            attn_pv<64, 2>(tp, pf, Vt + (kb & 3) * 10240, lane);
        }
    }
    if (wact) {
#pragma unroll
        for (int u = 0; u < 2; ++u) { const int tl = 8 * w + 4 * u + (fr >> 2); const size_t row = row0 + (sample ? (tl & 7) : tl); bf16_t* dst = p.OCMP + row * 1024 + (kv * 4 + (fr & 3)) * 64;
#pragma unroll
            for (int dt = 0; dt < 4; ++dt) { u32x2 wv; wv.x = cvt_pk_bf16(T[u].o[dt][0], T[u].o[dt][1]); wv.y = cvt_pk_bf16(T[u].o[dt][2], T[u].o[dt][3]); *(u32x2*)(dst + 16 * dt + 4 * g) = wv; } }
        asm volatile("s_waitcnt lgkmcnt(0)" ::: "memory");
        const int tk = lane >> 3, sub = lane & 7, tl = (sample ? 0 : 8 * w) + tk, cur = qt;
        unsigned key[16];
#pragma unroll
        for (int i = 0; i < 16; ++i) { const int j = 16 * sub + i; const float sc = SC[tl * 128 + j];
            const bool forced = (j == 0) || (j == cur) || (j == cur - 1), valid = j <= cur;
            key[i] = fkey(forced ? 1e9f : (valid ? sc : -1.0f)); }
        unsigned thr = 0u;
        for (int bit = 31; bit >= 0; --bit) { const unsigned cand = thr | (1u << bit); int c = 0;
#pragma unroll
            for (int i = 0; i < 16; ++i) c += (key[i] >= cand) ? 1 : 0;
            c = gsum8(c); if (c >= 16) thr = cand; }
        unsigned gtm = 0u, eqm = 0u;
#pragma unroll
        for (int i = 0; i < 16; ++i) { gtm |= (key[i] > thr) ? (1u << i) : 0u; eqm |= (key[i] == thr) ? (1u << i) : 0u; }
        const int ngt = gsum8(__popc(gtm)), neq = __popc(eqm);
        int pre = neq;
        { int v = __shfl_up(pre, 1); if (sub >= 1) pre += v; v = __shfl_up(pre, 2); if (sub >= 2) pre += v; v = __shfl_up(pre, 4); if (sub >= 4) pre += v; }
        int take = (16 - ngt) - (pre - neq); take = take < 0 ? 0 : (take > neq ? neq : take);
        unsigned sel = gtm, em = eqm;
        for (int i = 0; i < take; ++i) { const unsigned low = em & (0u - em); sel |= low; em ^= low; }
        unsigned vm = 0u;
#pragma unroll
        for (int i = 0; i < 16; ++i) vm |= (16 * sub + i <= cur) ? (1u << i) : 0u;
        sel &= vm;
        const unsigned hi = __shfl_down(sel, 1);
        if ((sub & 1) == 0) p.SEL[(row0 + (sample ? tk : 8 * w + tk)) * 16 + kv * 4 + (sub >> 1)] = sel | (hi << 16);
    }
}

__device__ __forceinline__ void slc_merge_store(const Params& p, const AttnTile<64>& T, size_t row, int kv, int lane) {
    const int fr = lane & 15, g = lane >> 4, head = kv * 4 + (fr & 3); const size_t base = row * 1024 + head * 64;
    const float inv = 1.0f / fmaxf(xsum16_32(T.l), 1e-30f);
    const float gc = p.NG[row * 48 + head], gs = p.NG[row * 48 + 16 + head], gw = p.NG[row * 48 + 32 + head];
    u32x2 ga[4], gb[4], hg[4], oc[4], ow[4];
#pragma unroll
    for (int dt = 0; dt < 4; ++dt) { const size_t o = base + 16 * dt + 4 * g; ga[dt] = *(const u32x2*)(p.GA + o); gb[dt] = *(const u32x2*)(p.GB + o); hg[dt] = *(const u32x2*)(p.OHG + o); oc[dt] = *(const u32x2*)(p.OCMP + o); ow[dt] = *(const u32x2*)(p.OWIN + o); }
#pragma unroll
    for (int dt = 0; dt < 4; ++dt) { const size_t o = base + 16 * dt + 4 * g;
        float r[4];
        r[0] = lo_bf(ga[dt].x) * lo_bf(hg[dt].x) + lo_bf(gb[dt].x) * (gc * lo_bf(oc[dt].x) + gs * T.o[dt][0] * inv + gw * lo_bf(ow[dt].x));
        r[1] = hi_bf(ga[dt].x) * hi_bf(hg[dt].x) + hi_bf(gb[dt].x) * (gc * hi_bf(oc[dt].x) + gs * T.o[dt][1] * inv + gw * hi_bf(ow[dt].x));
        r[2] = lo_bf(ga[dt].y) * lo_bf(hg[dt].y) + lo_bf(gb[dt].y) * (gc * lo_bf(oc[dt].y) + gs * T.o[dt][2] * inv + gw * lo_bf(ow[dt].y));
        r[3] = hi_bf(ga[dt].y) * hi_bf(hg[dt].y) + hi_bf(gb[dt].y) * (gc * hi_bf(oc[dt].y) + gs * T.o[dt][3] * inv + gw * hi_bf(ow[dt].y));
        u32x2 wv; wv.x = cvt_pk_bf16(r[0], r[1]); wv.y = cvt_pk_bf16(r[2], r[3]); *(u32x2*)(p.MERGED + o) = wv; }
}
constexpr int S_BUF = 4 * (8192 + 10240);
constexpr int W_TILE = 8192 + 10240;
__device__ __forceinline__ void wave_partials_put(LAS float* PX, const AttnTile<64> (&T)[2], int w, int lane) {
#pragma unroll
    for (int u = 0; u < 2; ++u) { LAS float* d = PX + (size_t)((w * 2 + u) * 18) * 64 + lane;
#pragma unroll
        for (int k = 0; k < 16; ++k) d[k * 64] = T[u].o[k >> 2][k & 3];
        d[16 * 64] = T[u].m; d[17 * 64] = T[u].l; }
}
__device__ __forceinline__ void wave_partials_merge(const LAS float* PX, AttnTile<64>& R, int u, int lane, float c) {
    float M = NEG_INF;
#pragma unroll
    for (int ww = 0; ww < 8; ++ww) M = fmaxf(M, PX[(size_t)((ww * 2 + u) * 18 + 16) * 64 + lane]);
    const float Ms = (M == NEG_INF) ? 0.f : M;
    R.init(); R.m = M;
#pragma unroll
    for (int ww = 0; ww < 8; ++ww) { const LAS float* s = PX + (size_t)((ww * 2 + u) * 18) * 64 + lane; const float f = __builtin_amdgcn_exp2f(s[16 * 64] - Ms);
        R.l += s[17 * 64] * f;
#pragma unroll
        for (int k = 0; k < 16; ++k) R.o[k >> 2][k & 3] += s[k * 64] * f; }
}
__device__ __forceinline__ void slc_unit_sample(const Params& p, int unit, LAS unsigned char* lds) {
    constexpr float QSC = ATT_C;
    const int lane = TID() & 63, w = TID() >> 6, fr = lane & 15, g = lane >> 4;
    const int b = unit >> 2, kv = unit & 3; const size_t row0 = (size_t)MP + b * 8;
    AttnTile<64> T[2]; unsigned sel0[2], sel1[2]; int tok[2];
#pragma unroll
    for (int u = 0; u < 2; ++u) { T[u].init(); tok[u] = 4 * u + (fr >> 2); const size_t row = row0 + tok[u];
        const bf16_t* q = p.QR + row * 1024 + (kv * 4 + (fr & 3)) * 64 + 8 * g; T[u].q[0] = ldq_scaled(q, QSC); T[u].q[1] = ldq_scaled(q + 32, QSC);
        sel0[u] = p.SEL[row * 16 + kv * 4]; sel1[u] = p.SEL[row * 16 + kv * 4 + 1]; }
    LAS unsigned char* Kt = lds + 1024 + w * W_TILE; LAS unsigned char* Vt = Kt + 8192;
    __syncthreads();
    for (int j = w; j <= PAST / 64; j += 8) {
        bool mybit[2], act[2];
#pragma unroll
        for (int u = 0; u < 2; ++u) { mybit[u] = ((j < 32 ? sel0[u] >> j : sel1[u]) & 1u) != 0u; act[u] = __ballot(mybit[u]) != 0ull; }
        if (!act[0] && !act[1]) continue;
        if (j < PAST / 64) {
            const int page = p.page_table[b * NPAGES + (j >> 1)]; const float* src = p.cache_slc + ((size_t)page * PAGE + (j & 1) * 64) * 512 + kv * 64;
            stage_kv_f32_block(src, 512, lane, Kt, Vt, nullptr, 0, 0);
        } else {
#pragma unroll
            for (int i = 0; i < 8; ++i) { st_k_item(Kt, lane + 64 * i, ld_bf16_item(p.SKs + ((size_t)kv * MS + b * 8) * 64, lane + 64 * i, 8)); st_v_item(Vt, lane + 64 * i, ld_bf16_item(p.SVs + ((size_t)kv * MS + b * 8) * 64, lane + 64 * i, 8)); }
        }
        const int kbase = j * 64;
        attn_block_sel(T, act[0], act[1], Kt, Vt, ATT_C, [&](int u) { return mybit[u]; }, j == PAST / 64, [&](int u, int kl) { return kbase + kl <= PAST + tok[u]; }, lane);
    }
    __syncthreads();
    LAS float* PX = (LAS float*)(lds + 1024);
    wave_partials_put(PX, T, w, lane);
    __syncthreads();
    if (w < 2) { AttnTile<64> R; wave_partials_merge(PX, R, w, lane, ATT_C); slc_merge_store(p, R, row0 + 4 * w + (fr >> 2), kv, lane); }
}

__device__ __forceinline__ void win_unit_sample(const Params& p, int unit, LAS unsigned char* lds) {
    constexpr float QSC = ATT_C;
    const int lane = TID() & 63, w = TID() >> 6, fr = lane & 15, g = lane >> 4;
    const int b = unit >> 2, kv = unit & 3; const size_t row0 = (size_t)MP + b * 8;
    AttnTile<64> T[2];
#pragma unroll
    for (int u = 0; u < 2; ++u) { T[u].init(); const size_t row = row0 + 4 * u + (fr >> 2);
        const bf16_t* q = p.QR + row * 1024 + (kv * 4 + (fr & 3)) * 64 + 8 * g; T[u].q[0] = ldq_scaled(q, QSC); T[u].q[1] = ldq_scaled(q + 32, QSC); }
    LAS unsigned char* Kt = lds + 1024 + w * W_TILE; LAS unsigned char* Vt = Kt + 8192;
    __syncthreads();
    for (int kb = w; kb < 9; kb += 8) {
        if (kb < 8) {
            const float* src = p.cache_win + ((size_t)b * WIN + kb * 64) * 512 + kv * 64;
            float* cp = p.out + OFF_SWIN + ((size_t)b * WIN + kb * 64 - DSEQ) * 512 + kv * 64;
            const int cf = kb == 0 ? DSEQ : 0;
            stage_kv_f32_block(src, 512, lane, Kt, Vt, cp, 512, cf);
        } else {
#pragma unroll
            for (int i = 0; i < 8; ++i) { st_k_item(Kt, lane + 64 * i, ld_bf16_item(p.WKs + ((size_t)kv * MS + b * 8) * 64, lane + 64 * i, 8)); st_v_item(Vt, lane + 64 * i, ld_bf16_item(p.WVs + ((size_t)kv * MS + b * 8) * 64, lane + 64 * i, 8)); }
        }
        attn_block2<64>(T, Kt, Vt, ATT_C, kb == 0 || kb == 8, [&](int u, int kl) { const int tok = 4 * u + (fr >> 2); return kb == 0 ? (kl > tok) : (kl <= tok); }, lane);
    }
    __syncthreads();
    LAS float* PX = (LAS float*)(lds + 1024);
    wave_partials_put(PX, T, w, lane);
    __syncthreads();
    if (w < 2) { AttnTile<64> R; wave_partials_merge(PX, R, w, lane, ATT_C); const size_t row = row0 + 4 * w + (fr >> 2); attn_store_bf16<64>(R, p.OWIN + row * 1024 + (kv * 4 + (fr & 3)) * 64, lane); }
}

__device__ __forceinline__ void win_unit_prompt(const Params& p, int unit, LAS unsigned char* lds) {
    constexpr float QSC = ATT_C;
    const int tid = TID(), lane = tid & 63, w = tid >> 6, fr = lane & 15, g = lane >> 4;
    const int b = unit >> 9, kv = (unit >> 7) & 3, qt = unit & 127, t0 = qt * 64;
    AttnTile<64> T[2];
#pragma unroll
    for (int u = 0; u < 2; ++u) { T[u].init(); const size_t row = (size_t)b * SEQ + t0 + 8 * w + 4 * u + (fr >> 2);
        const bf16_t* q = p.QR + row * 1024 + (kv * 4 + (fr & 3)) * 64 + 8 * g; T[u].q[0] = ldq_scaled(q, QSC); T[u].q[1] = ldq_scaled(q + 32, QSC); }
    const int kb0 = qt >= 8 ? qt - 8 : 0, nb = qt - kb0 + 1, nround = (nb + 1) >> 1;
    const bf16_t* Kg = p.WKp + ((size_t)kv * MP + (size_t)b * SEQ + (size_t)kb0 * 64) * 64; const bf16_t* Vg = p.WVp + ((size_t)kv * MP + (size_t)b * SEQ + (size_t)kb0 * 64) * 64;
    u32x4 rk[2], rv[2];
#pragma unroll
    for (int jj = 0; jj < 2; ++jj) if (jj < nb) { rk[jj] = ld_bf16_item(Kg + (size_t)jj * 4096, tid, 64); rv[jj] = ld_bf16_item(Vg + (size_t)jj * 4096, tid, 64); }
    __syncthreads();
#pragma unroll
    for (int jj = 0; jj < 2; ++jj) if (jj < nb) { st_k_item(lds + 1024 + jj * 8192, tid, rk[jj]); st_v_item(lds + 1024 + 32768 + jj * 10240, tid, rv[jj]); }
    __syncthreads();
    for (int r = 0; r < nround; ++r) {
        const LAS unsigned char* buf = lds + 1024 + (r & 1) * S_BUF;
        const bool more = r + 1 < nround;
        if (more) {
#pragma unroll
            for (int jj = 0; jj < 2; ++jj) { const int j = 2 * (r + 1) + jj; if (j < nb) { rk[jj] = ld_bf16_item(Kg + (size_t)j * 4096, tid, 64); rv[jj] = ld_bf16_item(Vg + (size_t)j * 4096, tid, 64); } }
        }
#pragma unroll
        for (int jj = 0; jj < 2; ++jj) { const int j = 2 * r + jj; if (j >= nb) break;
            const int kb = kb0 + j, kbase = kb * 64;
            attn_block2<64>(T, buf + jj * 8192, buf + 32768 + jj * 10240, ATT_C, kb == qt || kb == qt - 8, [&](int u, int kl) { const int qpos = t0 + 8 * w + 4 * u + (fr >> 2), kpos = kbase + kl; return kpos <= qpos && kpos > qpos - WIN; }, lane);
        }
        if (more) {
            LAS unsigned char* nbuf = lds + 1024 + ((r + 1) & 1) * S_BUF;
#pragma unroll
            for (int jj = 0; jj < 2; ++jj) { const int j = 2 * (r + 1) + jj; if (j < nb) { st_k_item(nbuf + jj * 8192, tid, rk[jj]); st_v_item(nbuf + 32768 + jj * 10240, tid, rv[jj]); } }
        }
        __syncthreads();
    }
#pragma unroll
    for (int u = 0; u < 2; ++u) { const int qpos = t0 + 8 * w + 4 * u + (fr >> 2);
        if (qpos < WIN - 1) { const float mnew = fmaxf(T[u].m, 0.f), alpha = __builtin_amdgcn_exp2f(T[u].m - mnew);
            T[u].l = T[u].l * alpha + (g == 0 ? (float)(WIN - 1 - qpos) * __builtin_amdgcn_exp2f(-mnew) : 0.f); T[u].m = mnew;
#pragma unroll
            for (int dt = 0; dt < 4; ++dt) T[u].o[dt] *= alpha; } }
#pragma unroll
    for (int u = 0; u < 2; ++u) { const size_t row = (size_t)b * SEQ + t0 + 8 * w + 4 * u + (fr >> 2); attn_store_bf16<64>(T[u], p.OWIN + row * 1024 + (kv * 4 + (fr & 3)) * 64, lane); }
}

constexpr int R_FLAGS = 1024 + 8 * W_TILE;
__device__ __forceinline__ unsigned lds_ld_u32(const volatile LAS unsigned* p) { return *p; }
__device__ __forceinline__ void slc_unit_prompt_ring(const Params& p, int unit, LAS unsigned char* lds) {
    constexpr float QSC = ATT_C;
    const int tid = TID(), lane = tid & 63, w = __builtin_amdgcn_readfirstlane(tid >> 6), fr = lane & 15, g = lane >> 4;
    const int b = unit >> 9, kv = (unit >> 7) & 3, cur = unit & 127, t0 = cur * 64; const size_t row0 = (size_t)b * SEQ + t0;
    AttnTile<64> T[2]; unsigned selw[2][4]; int qpos[2]; size_t rowu[2];
#pragma unroll
    for (int u = 0; u < 2; ++u) { T[u].init(); const int tl = 8 * w + 4 * u + (fr >> 2); qpos[u] = t0 + tl; rowu[u] = row0 + tl;
        const bf16_t* q = p.QR + rowu[u] * 1024 + (kv * 4 + (fr & 3)) * 64 + 8 * g; T[u].q[0] = ldq_scaled(q, QSC); T[u].q[1] = ldq_scaled(q + 32, QSC);
        const u32x4 sw = *(const u32x4*)(p.SEL + rowu[u] * 16 + kv * 4); selw[u][0] = sw.x; selw[u][1] = sw.y; selw[u][2] = sw.z; selw[u][3] = sw.w; }
    const bf16_t* Kg = p.SKp + ((size_t)kv * MP + (size_t)b * SEQ) * 64; const bf16_t* Vg = p.SVp + ((size_t)kv * MP + (size_t)b * SEQ) * 64;
    volatile LAS unsigned* ready = (volatile LAS unsigned*)(lds + R_FLAGS); volatile LAS unsigned* done = ready + 8;
    u32x4 rk[8], rv[8];
    auto issue = [&](int pb) {
#pragma unroll
        for (int i = 0; i < 8; ++i) { rk[i] = *(const u32x4*)(Kg + (size_t)pb * 4096 + (size_t)(lane + 64 * i) * 8); rv[i] = *(const u32x4*)(Vg + (size_t)pb * 4096 + (size_t)(lane + 64 * i) * 8); }
    };
    auto commit = [&](int pb) {
        const int slot = pb & 7; const unsigned want = 8u * (unsigned)(pb >> 3);
        unsigned spins = 0; while (lds_ld_u32(done + slot) < want && ++spins < (1u << 22)) __builtin_amdgcn_s_sleep(1);
        LAS unsigned char* Kt = lds + 1024 + slot * W_TILE; LAS unsigned char* Vt = Kt + 8192;
#pragma unroll
        for (int i = 0; i < 8; ++i) { st_k_item(Kt, lane + 64 * i, rk[i]); st_v_item(Vt, lane + 64 * i, rv[i]); }
        asm volatile("s_waitcnt lgkmcnt(0)" ::: "memory");
        if (lane == 0) ready[slot] = (unsigned)(pb >> 3) + 1u;
    };
    __syncthreads();
    if (tid < 16) ready[tid] = 0u;
    __syncthreads();
    if (w <= cur) { issue(w); commit(w); }
    for (int j = 0; j <= cur; ++j) {
        const int pc = j + 3;
        if (pc >= 8 && pc <= cur && (pc & 7) == w) { issue(pc); commit(pc); }
        const int slot = j & 7;
        bool mybit[2], act[2];
#pragma unroll
        for (int u = 0; u < 2; ++u) { const unsigned wd = (j >> 5) == 0 ? selw[u][0] : (j >> 5) == 1 ? selw[u][1] : (j >> 5) == 2 ? selw[u][2] : selw[u][3]; mybit[u] = (wd >> (j & 31)) & 1u; act[u] = __ballot(mybit[u]) != 0ull; }
        if (act[0] || act[1]) {
            const unsigned want = (unsigned)(j >> 3) + 1u;
            unsigned spins = 0; while (lds_ld_u32(ready + slot) < want && ++spins < (1u << 22)) __builtin_amdgcn_s_sleep(1);
            const LAS unsigned char* Kt = lds + 1024 + slot * W_TILE;
            const int kbase = j * 64;
            attn_block_sel(T, act[0], act[1], Kt, Kt + 8192, ATT_C, [&](int u) { return mybit[u]; }, j == cur, [&](int u, int kl) { return kbase + kl <= qpos[u]; }, lane);
            asm volatile("s_waitcnt lgkmcnt(0)" ::: "memory");
        }
        if (lane == 0) __hip_atomic_fetch_add((LAS unsigned*)(done + slot), 1u, __ATOMIC_RELAXED, __HIP_MEMORY_SCOPE_WORKGROUP);
    }
#pragma unroll
    for (int u = 0; u < 2; ++u) slc_merge_store(p, T[u], rowu[u], kv, lane);
}
struct EpiCmp {
    static constexpr bool PERM = true, AFTER_DRAIN = false;
    bf16_t* C;
    __device__ __forceinline__ void operator()(const f32x4 (&acc)[2][2][4][2], const pg8::Unit& u, int wr, int wc, int fr, int fq) const {
        EPI_FOR_FRAGS({ *(u32x4*)(C + (size_t)row * 256 + cl) = pack8(v0, v1); })
    }
    __device__ __forceinline__ void small(int row, int col, const f32x4 a0, const f32x4 a1, int) const { *(u32x4*)(C + (size_t)row * 256 + col) = pack8(a0, a1); }
};
__device__ __forceinline__ float gelu_tanh(float x) { const float y = 0.7978845608028654f * (x + 0.044715f * x * x * x); const float e = fast_exp(2.0f * y); return x * (1.0f - __builtin_amdgcn_rcpf(1.0f + e)); }
__device__ __forceinline__ void cmp_stage2(const Params& p) {
    const int lane = TID() & 63, fr = lane & 15, g = lane >> 4;
    const int gw = blockIdx.x * 8 + (TID() >> 6), nw = gridDim.x * 8;
    constexpr int NT_P = 2 * 8 * 32, NT_S = 2 * 512 * 8;
    for (int tile = gw; tile < NT_P + NT_S; tile += nw) {
        int sel, grp, i0, ntok; size_t arow0; bf16_t* dst;
        if (tile < NT_P) { sel = tile >> 8; grp = (tile >> 5) & 7; i0 = (tile & 31) * 16; ntok = NCMP_P; const int kv = grp >> 1, b = grp & 1;
            arow0 = (size_t)sel * 69632 + grp * 512; dst = (sel ? p.VCp : p.KCp) + (size_t)(b * 4 + kv) * 512 * 64; }
        else { const int t2 = tile - NT_P; sel = t2 >> 12; grp = (t2 >> 3) & 511; i0 = (t2 & 7) * 16; ntok = NCMP_S; const int kv = grp >> 7, b = grp & 127;
            arow0 = (size_t)sel * 69632 + 4096 + (size_t)grp * 128; dst = (sel ? p.VCs : p.KCs) + (size_t)(b * 4 + kv) * 128 * 64; }
        const int i = i0 + fr; const bool ok = i < ntok; const int ic = ok ? i : ntok - 1;
        const bf16_t* c1 = (const bf16_t*)p.CCp + (arow0 + ic) * 256; const bf16_t* c2 = (const bf16_t*)p.CCp + (arow0 + ic + 1) * 256 + 128;
        f32x4 acc[4];
#pragma unroll
        for (int nt = 0; nt < 4; ++nt) acc[nt] = (f32x4){0.f, 0.f, 0.f, 0.f};
#pragma unroll
        for (int ks = 0; ks < 4; ++ks) {
            const int h = 32 * ks + 8 * g; float hv[8];
            { const u32x4 a = *(const u32x4*)(c1 + h), b2 = *(const u32x4*)(c2 + h); const f32x4 pb0 = *(const f32x4*)(p.posb + sel * 128 + h), pb1 = *(const f32x4*)(p.posb + sel * 128 + h + 4);
                hv[0] = gelu_tanh(lo_bf(a.x) + lo_bf(b2.x) + pb0[0]); hv[1] = gelu_tanh(hi_bf(a.x) + hi_bf(b2.x) + pb0[1]); hv[2] = gelu_tanh(lo_bf(a.y) + lo_bf(b2.y) + pb0[2]); hv[3] = gelu_tanh(hi_bf(a.y) + hi_bf(b2.y) + pb0[3]);
                hv[4] = gelu_tanh(lo_bf(a.z) + lo_bf(b2.z) + pb1[0]); hv[5] = gelu_tanh(hi_bf(a.z) + hi_bf(b2.z) + pb1[1]); hv[6] = gelu_tanh(lo_bf(a.w) + lo_bf(b2.w) + pb1[2]); hv[7] = gelu_tanh(hi_bf(a.w) + hi_bf(b2.w) + pb1[3]); }
            u32x4 w; w.x = cvt_pk_bf16(hv[0], hv[1]); w.y = cvt_pk_bf16(hv[2], hv[3]); w.z = cvt_pk_bf16(hv[4], hv[5]); w.w = cvt_pk_bf16(hv[6], hv[7]);
            const bf16x8 af = __builtin_bit_cast(bf16x8, w);
#pragma unroll
            for (int nt = 0; nt < 4; ++nt) { const bf16x8 bfr = *(const bf16x8*)(p.W2t + (size_t)sel * 64 * 128 + (size_t)(16 * nt + fr) * 128 + h); acc[nt] = __builtin_amdgcn_mfma_f32_16x16x32_bf16(bfr, af, acc[nt], 0, 0, 0); }
        }
        if (ok) {
#pragma unroll
            for (int nt = 0; nt < 4; ++nt) { u32x2 wv; wv.x = cvt_pk_bf16(acc[nt][0], acc[nt][1]); wv.y = cvt_pk_bf16(acc[nt][2], acc[nt][3]); *(u32x2*)(dst + (size_t)i * 64 + 16 * nt + 4 * g) = wv; }
        }
    }
}


constexpr int CG_BT = 1024, CG_BTB = 256 * 64 * 2;
__device__ __forceinline__ void cmp_gemm_sample_unit(const Params& p, int upair, LAS unsigned char* lds) {
    const int tid = TID(), lane = tid & 63, w = tid >> 6, fr = lane & 15, g = lane >> 4;
    const int sel = upair >> 8, kv = (upair >> 6) & 3, b0 = (upair & 63) * 2;
    const bf16_t* Bg = p.W1t + (size_t)sel * 256 * 1024;
    const float* arow[2];
#pragma unroll
    for (int ub = 0; ub < 2; ++ub) { const int n = 16 * w + fr; const int page = p.page_table[(b0 + ub) * NPAGES + (n >> 3)];
        arow[ub] = p.cache_cmp + ((size_t)page * PAGE + (n & 7) * 16) * 512 + sel * 256 + kv * 64 + 8 * g; }
    f32x4 acc[2][16];
#pragma unroll
    for (int ub = 0; ub < 2; ++ub)
#pragma unroll
        for (int nt = 0; nt < 16; ++nt) acc[ub][nt] = (f32x4){0.f, 0.f, 0.f, 0.f};
    f32x4 ra[2][2][2];
    u32x4 rb[4];
    auto lda = [&](int s) {
#pragma unroll
        for (int ub = 0; ub < 2; ++ub)
#pragma unroll
            for (int ks = 0; ks < 2; ++ks) { const float* q = arow[ub] + (size_t)s * 512 + 32 * ks; ra[ub][ks][0] = *(const f32x4*)q; ra[ub][ks][1] = *(const f32x4*)(q + 4); } };
    auto ldb = [&](int s) {
#pragma unroll
        for (int i = 0; i < 4; ++i) { const int c = tid + 512 * i, col = c >> 3, ch = c & 7; rb[i] = *(const u32x4*)(Bg + (size_t)col * 1024 + s * 64 + ch * 8); } };
    auto stb = [&](LAS unsigned char* Bt) {
#pragma unroll
        for (int i = 0; i < 4; ++i) { const int c = tid + 512 * i, col = c >> 3, ch = c & 7; *(LAS u32x4*)(Bt + ktile_byte<64>(col, ch * 8)) = rb[i]; } };
    lda(0); ldb(0);
    __syncthreads();
    stb(lds + CG_BT);
    __syncthreads();
    for (int s = 0; s < 16; ++s) {
        bf16x8 af[2][2];
#pragma unroll
        for (int ub = 0; ub < 2; ++ub)
#pragma unroll
            for (int ks = 0; ks < 2; ++ks) af[ub][ks] = __builtin_bit_cast(bf16x8, pack8(ra[ub][ks][0], ra[ub][ks][1]));
        if (s < 15) { lda(s + 1); ldb(s + 1); }
        __builtin_amdgcn_sched_barrier(0);
        const LAS unsigned char* Bt = lds + CG_BT + (s & 1) * CG_BTB;
#pragma unroll
        for (int ks = 0; ks < 2; ++ks)
#pragma unroll
            for (int nt = 0; nt < 16; ++nt) { const bf16x8 bfr = *(const LAS bf16x8*)(Bt + ktile_byte<64>(16 * nt + fr, 32 * ks + 8 * g));
#pragma unroll
                for (int ub = 0; ub < 2; ++ub) acc[ub][nt] = __builtin_amdgcn_mfma_f32_16x16x32_bf16(bfr, af[ub][ks], acc[ub][nt], 0, 0, 0); }
        if (s < 15) stb(lds + CG_BT + ((s + 1) & 1) * CG_BTB);
        __syncthreads();
    }
#pragma unroll
    for (int ub = 0; ub < 2; ++ub) {
        bf16_t* C = (bf16_t*)p.CCp + ((size_t)sel * 69632 + 4096 + (size_t)(kv * 128 + b0 + ub) * 128 + 16 * w + fr) * 256;
#pragma unroll
        for (int nt = 0; nt < 16; ++nt) { u32x2 wv; wv.x = cvt_pk_bf16(acc[ub][nt][0], acc[ub][nt][1]); wv.y = cvt_pk_bf16(acc[ub][nt][2], acc[ub][nt][3]); *(u32x2*)(C + 16 * nt + 4 * g) = wv; }
    }
}

template <int HDV> __device__ __forceinline__ int vt_byte(int row, int col) { return row * (HDV * 2 + 32) + col * 2; }
constexpr int H_GL = 1024, H_QT = H_GL + 64 * 132 * 4, H_KT = H_QT + 16384, H_KE = H_KT + 16384, H_V = H_KE + 64 * 288, H_ST = H_V + 64 * 288, H_VEC = H_ST + 32768, H_END = H_VEC + 24 * 128 * 4;
static_assert(H_END <= 160 * 1024 - 64, "HGRN LDS map too large");

template <bool OUT> __device__ __forceinline__ void hgrn_task(const Params& p, int task, LAS unsigned char* lds) {
    const int tid = TID(), lane = tid & 63, w = tid >> 6, fr = lane & 15, g = lane >> 4;
    const int b = task >> 8, h = (task >> 5) & 7, sc = task & 31;
    const size_t row0 = (size_t)b * SEQ + sc * 256;
    LAS float* GL = (LAS float*)(lds + H_GL);
    LAS unsigned char* QT = lds + H_QT;
    LAS unsigned char* KT = lds + H_KT;
    LAS unsigned char* KE = lds + H_KE;
    LAS unsigned char* VV = lds + H_V;
    LAS unsigned char* ST = lds + H_ST;
    LAS float* VEC = (LAS float*)(lds + H_VEC);
    f32x4 sacc[8];
#pragma unroll
    for (int vt = 0; vt < 8; ++vt) sacc[vt] = (f32x4){0.f, 0.f, 0.f, 0.f};
    __syncthreads();
    if (OUT) {
        const float* S0 = p.Lloc + (size_t)task * 16384;
#pragma unroll
        for (int vt = 0; vt < 8; ++vt)
#pragma unroll
            for (int r = 0; r < 4; ++r) sacc[vt][r] = S0[(size_t)(16 * w + 4 * g + r) * 128 + 16 * vt + fr];
    } else if (tid < 128) VEC[9 * 128 + tid] = 0.f;
    for (int step = 0; step < 4; ++step) {
        const size_t r0 = row0 + step * 64;
        const int k = tid & 127, sub = tid >> 7;
        float gl[16], gr[16], gsum = 0.f;
#pragma unroll
        for (int i = 0; i < 16; ++i) gr[i] = p.G[(r0 + sub * 16 + i) * 1024 + h * 128 + k];
#pragma unroll
        for (int i = 0; i < 16; ++i) { gsum += gr[i]; gl[i] = gsum; }
        VEC[sub * 128 + k] = gsum;
        if (OUT) {
#pragma unroll
            for (int vt = 0; vt < 8; ++vt) { u32x2 wv; wv.x = cvt_pk_bf16(sacc[vt][0], sacc[vt][1]); wv.y = cvt_pk_bf16(sacc[vt][2], sacc[vt][3]); *(LAS u32x2*)(ST + ktile_byte<128>(16 * vt + fr, 16 * w + 4 * g)) = wv; }
        }
        {
            const int s = tid >> 3, ch = tid & 7;
            const u32x4 a = *(const u32x4*)(p.HV + (r0 + s) * 1024 + h * 128 + ch * 16), b2 = *(const u32x4*)(p.HV + (r0 + s) * 1024 + h * 128 + ch * 16 + 8);
            *(LAS u32x4*)(VV + vt_byte<128>(s, ch * 16)) = a; *(LAS u32x4*)(VV + vt_byte<128>(s, ch * 16 + 8)) = b2;
        }
        __syncthreads();
        {
            float bi = 0.f, gend = 0.f;
#pragma unroll
            for (int i = 0; i < 4; ++i) { const float tv = VEC[i * 128 + k]; if (i < sub) bi += tv; gend += tv; }
            const float gmid = gl[7];
            if (sub == 0) { VEC[8 * 128 + k] = gend; }
            VEC[(4 + sub) * 128 + k] = bi + gmid;
            const float etail = gend - bi;
#pragma unroll
            for (int i = 0; i < 16; ++i) {
                const int t = sub * 16 + i;
                const float kk = 1.0f - fast_exp(gr[i]);
                if (OUT) { const float qv = bf2f(p.HQ[(r0 + t) * 1024 + h * 128 + k]);
                    *(LAS bf16_t*)(QT + ktile_byte<128>(t, k)) = f2bf(qv * fast_exp(gl[i] - gmid));
                    *(LAS bf16_t*)(KT + ktile_byte<128>(t, k)) = f2bf(kk * fast_exp(gmid - gl[i])); }
                *(LAS bf16_t*)(KE + vt_byte<128>(t, k)) = f2bf(kk * fast_exp(etail - gl[i]));
            }
        }
        __syncthreads();
        if (OUT) {
            for (int e = tid; e < 10 * 128; e += 512) { const int rowi = e >> 7, kx = e & 127;
                float v;
                if (rowi < 4) v = fast_exp(VEC[(4 + rowi) * 128 + kx]);
                else { const int pr = rowi - 4, pi = pr == 0 ? 1 : pr < 3 ? 2 : 3, pj = pr == 0 ? 0 : pr == 1 ? 0 : pr == 2 ? 1 : pr - 3; v = fast_exp(VEC[(4 + pi) * 128 + kx] - VEC[(4 + pj) * 128 + kx]); }
                VEC[(12 + rowi) * 128 + kx] = v; }
            __syncthreads();
            const int ti = w & 3, vh = w >> 2;
            bf16x8 qf[4];
#pragma unroll
            for (int ks = 0; ks < 4; ++ks) qf[ks] = *(const LAS bf16x8*)(QT + ktile_byte<128>(16 * ti + fr, 32 * ks + 8 * g));
            f32x4 at[4];
#pragma unroll
            for (int sj = 0; sj < 4; ++sj) { at[sj] = (f32x4){0.f, 0.f, 0.f, 0.f};
                if (sj <= ti) {
#pragma unroll
                    for (int ks = 0; ks < 4; ++ks) {
                        bf16x8 qs = qf[ks];
                        if (sj < ti) { float f[8]; const int prow = 16 + (ti == 1 ? 0 : ti == 2 ? 1 + sj : 3 + sj);
                            const f32x4 d0 = *(const LAS f32x4*)(VEC + prow * 128 + 32 * ks + 8 * g), d1 = *(const LAS f32x4*)(VEC + prow * 128 + 32 * ks + 8 * g + 4);
#pragma unroll
                            for (int j = 0; j < 8; ++j) f[j] = bf2f((bf16_t)qf[ks][j]) * (j < 4 ? d0[j & 3] : d1[j & 3]);
                            u32x4 wv; wv.x = cvt_pk_bf16(f[0], f[1]); wv.y = cvt_pk_bf16(f[2], f[3]); wv.z = cvt_pk_bf16(f[4], f[5]); wv.w = cvt_pk_bf16(f[6], f[7]); qs = __builtin_bit_cast(bf16x8, wv); }
                        const bf16x8 kf = *(const LAS bf16x8*)(KT + ktile_byte<128>(16 * sj + fr, 32 * ks + 8 * g));
                        at[sj] = __builtin_amdgcn_mfma_f32_16x16x32_bf16(kf, qs, at[sj], 0, 0, 0);
                    }
                    if (sj == ti) {
#pragma unroll
                        for (int r = 0; r < 4; ++r) if (4 * g + r > fr) at[sj][r] = 0.f;
                    }
                } }
            bf16x8 pf[2];
#pragma unroll
            for (int ph = 0; ph < 2; ++ph) { u32x4 wv; wv.x = cvt_pk_bf16(at[2 * ph][0], at[2 * ph][1]); wv.y = cvt_pk_bf16(at[2 * ph][2], at[2 * ph][3]);
                wv.z = cvt_pk_bf16(at[2 * ph + 1][0], at[2 * ph + 1][1]); wv.w = cvt_pk_bf16(at[2 * ph + 1][2], at[2 * ph + 1][3]); pf[ph] = __builtin_bit_cast(bf16x8, wv); }
            bf16x8 qin[4];
#pragma unroll
            for (int ks = 0; ks < 4; ++ks) { float f[8]; const f32x4 d0 = *(const LAS f32x4*)(VEC + (12 + ti) * 128 + 32 * ks + 8 * g), d1 = *(const LAS f32x4*)(VEC + (12 + ti) * 128 + 32 * ks + 8 * g + 4);
#pragma unroll
                for (int j = 0; j < 8; ++j) f[j] = bf2f((bf16_t)qf[ks][j]) * (j < 4 ? d0[j & 3] : d1[j & 3]);
                u32x4 wv; wv.x = cvt_pk_bf16(f[0], f[1]); wv.y = cvt_pk_bf16(f[2], f[3]); wv.z = cvt_pk_bf16(f[4], f[5]); wv.w = cvt_pk_bf16(f[6], f[7]); qin[ks] = __builtin_bit_cast(bf16x8, wv); }
            f32x4 ot[4]; float ss = 0.f;
#pragma unroll
            for (int vi = 0; vi < 4; ++vi) { const int vt = 4 * vh + vi; ot[vi] = (f32x4){0.f, 0.f, 0.f, 0.f};
#pragma unroll
                for (int ks = 0; ks < 4; ++ks) { const bf16x8 sf = *(const LAS bf16x8*)(ST + ktile_byte<128>(16 * vt + fr, 32 * ks + 8 * g)); ot[vi] = __builtin_amdgcn_mfma_f32_16x16x32_bf16(sf, qin[ks], ot[vi], 0, 0, 0); }
#pragma unroll
                for (int ph = 0; ph < 2; ++ph) { if (2 * ph > ti) continue;
                    const LAS unsigned char* vb = VV + vt_byte<128>(32 * ph + 4 * g + (fr >> 2), 16 * vt + 4 * (fr & 3));
                    const s16x4 a = __builtin_amdgcn_ds_read_tr16_b64_v4i16((LAS s16x4*)vb), b2 = __builtin_amdgcn_ds_read_tr16_b64_v4i16((LAS s16x4*)(vb + 16 * 288));
                    const bf16x8 vf = {a[0], a[1], a[2], a[3], b2[0], b2[1], b2[2], b2[3]};
                    ot[vi] = __builtin_amdgcn_mfma_f32_16x16x32_bf16(vf, pf[ph], ot[vi], 0, 0, 0); }
                ss += ot[vi][0] * ot[vi][0] + ot[vi][1] * ot[vi][1] + ot[vi][2] * ot[vi][2] + ot[vi][3] * ot[vi][3];
            }
            ss = xsum16_32(ss);
            if (g == 0) VEC[(10 + vh) * 128 + 16 * ti + fr] = ss;
            __syncthreads();
            {
                const float tot = VEC[10 * 128 + 16 * ti + fr] + VEC[11 * 128 + 16 * ti + fr];
                const float rs = rsqrtf(tot * (1.0f / 128.0f) + RMS_EPS);
                const size_t row = r0 + 16 * ti + fr;
                f32x4 gn[4]; u32x2 og[4];
#pragma unroll
                for (int vi = 0; vi < 4; ++vi) { const int v0 = 16 * (4 * vh + vi) + 4 * g; gn[vi] = *(const f32x4*)(p.hg_gnorm + v0); og[vi] = *(const u32x2*)(p.HOG + row * 1024 + h * 128 + v0); }
#pragma unroll
                for (int vi = 0; vi < 4; ++vi) { const int v0 = 16 * (4 * vh + vi) + 4 * g;
                    u32x2 wv; wv.x = cvt_pk_bf16(ot[vi][0] * rs * gn[vi][0] * lo_bf(og[vi].x), ot[vi][1] * rs * gn[vi][1] * hi_bf(og[vi].x)); wv.y = cvt_pk_bf16(ot[vi][2] * rs * gn[vi][2] * lo_bf(og[vi].y), ot[vi][3] * rs * gn[vi][3] * hi_bf(og[vi].y));
                    *(u32x2*)(p.OHG + row * 1024 + h * 128 + v0) = wv; }
            }
        }
        {
            float dk[4];
#pragma unroll
            for (int r = 0; r < 4; ++r) dk[r] = fast_exp(VEC[8 * 128 + 16 * w + 4 * g + r]);
#pragma unroll
            for (int vt = 0; vt < 8; ++vt)
#pragma unroll
                for (int r = 0; r < 4; ++r) sacc[vt][r] *= dk[r];
#pragma unroll
            for (int ks = 0; ks < 2; ++ks) {
                const LAS unsigned char* kb = KE + vt_byte<128>(32 * ks + 8 * g + (fr >> 2), 16 * w + 4 * (fr & 3));
                const s16x4 ka = __builtin_amdgcn_ds_read_tr16_b64_v4i16((LAS s16x4*)kb), kb2 = __builtin_amdgcn_ds_read_tr16_b64_v4i16((LAS s16x4*)(kb + 4 * 288));
                const bf16x8 kf = {ka[0], ka[1], ka[2], ka[3], kb2[0], kb2[1], kb2[2], kb2[3]};
#pragma unroll
                for (int vt = 0; vt < 8; ++vt) {
                    const LAS unsigned char* vb = VV + vt_byte<128>(32 * ks + 8 * g + (fr >> 2), 16 * vt + 4 * (fr & 3));
                    const s16x4 va = __builtin_amdgcn_ds_read_tr16_b64_v4i16((LAS s16x4*)vb), vb2 = __builtin_amdgcn_ds_read_tr16_b64_v4i16((LAS s16x4*)(vb + 4 * 288));
                    const bf16x8 vf = {va[0], va[1], va[2], va[3], vb2[0], vb2[1], vb2[2], vb2[3]};
                    sacc[vt] = __builtin_amdgcn_mfma_f32_16x16x32_bf16(kf, vf, sacc[vt], 0, 0, 0);
                }
            }
            if (!OUT && tid < 128) VEC[9 * 128 + tid] += VEC[8 * 128 + tid];
        }
        __syncthreads();
    }
    if (!OUT) {
        float* L = p.Lloc + (size_t)task * 16384;
#pragma unroll
        for (int vt = 0; vt < 8; ++vt)
#pragma unroll
            for (int r = 0; r < 4; ++r) L[(size_t)(16 * w + 4 * g + r) * 128 + 16 * vt + fr] = sacc[vt][r];
        if (tid < 128) p.Dec[(size_t)task * 128 + tid] = fast_exp(VEC[9 * 128 + tid]);
    }
}

__device__ __forceinline__ void hgrn_scan(const Params& p) {
    for (int e0 = (blockIdx.x * 512 + TID()) * 2; e0 < 16 * 16384; e0 += gridDim.x * 1024) {
        const int bh = e0 >> 14, kvx = e0 & 16383, k = kvx >> 7;
        f32x2 L[32]; float d[32];
#pragma unroll
        for (int sc = 0; sc < 32; ++sc) { const size_t task = (size_t)bh * 32 + sc; L[sc] = *(const f32x2*)(p.Lloc + task * 16384 + kvx); d[sc] = p.Dec[task * 128 + k]; }
        f32x2 S = (f32x2){0.f, 0.f};
#pragma unroll
        for (int sc = 0; sc < 32; ++sc) { const size_t task = (size_t)bh * 32 + sc; *(f32x2*)(p.Lloc + task * 16384 + kvx) = S; S = S * d[sc] + L[sc]; }
        *(f32x2*)(p.out + OFF_PSTATE + (size_t)bh * 16384 + kvx) = S;
    }
}

__device__ __forceinline__ void hgrn_sample_tasks(const Params& p, LAS unsigned char* lds) {
    const int tid = TID(), v = tid & 127, kq = tid >> 7;
    LAS float* FV = (LAS float*)(lds + 1024);
    LAS float* QV = FV + 1024;
    LAS float* PART = QV + 1024;
    float s[32], sn[32];
    int task = blockIdx.x;
    if (task < 1024) { const float* S0 = p.state_hgrn + ((size_t)task * 128 + kq * 32) * 128 + v;
#pragma unroll
        for (int j = 0; j < 32; ++j) sn[j] = S0[(size_t)j * 128]; }
    for (; task < 1024; task += gridDim.x) {
        const int b = task >> 3, h = task & 7;
#pragma unroll
        for (int j = 0; j < 32; ++j) s[j] = sn[j];
        const int nxt = task + gridDim.x;
        if (nxt < 1024) { const float* S0 = p.state_hgrn + ((size_t)nxt * 128 + kq * 32) * 128 + v;
#pragma unroll
            for (int j = 0; j < 32; ++j) sn[j] = S0[(size_t)j * 128]; }
        __syncthreads();
        for (int i = tid; i < 1024; i += 512) { const size_t row = (size_t)MP + b * 8 + (i >> 7); const int k = i & 127;
            FV[i] = fast_exp(p.G[row * 1024 + h * 128 + k]); QV[i] = bf2f(p.HQ[row * 1024 + h * 128 + k]); }
        __syncthreads();
#pragma unroll 1
        for (int i = 0; i < 8; ++i) {
            const size_t row = (size_t)MP + b * 8 + i;
            const float vv = bf2f(p.HV[row * 1024 + h * 128 + v]);
            float o = 0.f;
#pragma unroll
            for (int j = 0; j < 32; ++j) { const float f = FV[i * 128 + kq * 32 + j]; s[j] = f * s[j] + (1.0f - f) * vv; o += QV[i * 128 + kq * 32 + j] * s[j]; }
            PART[(kq * 8 + i) * 128 + v] = o;
        }
        float* S1 = p.out + OFF_SSTATE + ((size_t)task * 128 + kq * 32) * 128 + v;
#pragma unroll
        for (int j = 0; j < 32; ++j) S1[(size_t)j * 128] = s[j];
        __syncthreads();
        {
            const int i = tid >> 6, l = tid & 63;
            float o0 = 0.f, o1 = 0.f;
#pragma unroll
            for (int q = 0; q < 4; ++q) { o0 += PART[(q * 8 + i) * 128 + l]; o1 += PART[(q * 8 + i) * 128 + 64 + l]; }
            float ss = o0 * o0 + o1 * o1;
#pragma unroll
            for (int d = 1; d < 64; d <<= 1) ss += __shfl_xor(ss, d);
            const float rs = rsqrtf(ss * (1.0f / 128.0f) + RMS_EPS);
            const size_t row = (size_t)MP + b * 8 + i;
            p.OHG[row * 1024 + h * 128 + l] = f2bf(o0 * rs * p.hg_gnorm[l] * bf2f(p.HOG[row * 1024 + h * 128 + l]));
            p.OHG[row * 1024 + h * 128 + 64 + l] = f2bf(o1 * rs * p.hg_gnorm[64 + l] * bf2f(p.HOG[row * 1024 + h * 128 + 64 + l]));
        }
    }
}
constexpr float MEM_C = 0.0625f * 1.44269504088896f;
constexpr int X_KT = 1024;
constexpr int X_BUF = 32768 + 34816;
__device__ __forceinline__ void xattn_unit_prompt(const Params& p, int unit, LAS unsigned char* lds) {
    const int b = unit >> 8, head = (unit >> 6) & 3, qb = unit & 63;
    const int tid = TID(), lane = tid & 63, w = tid >> 6, fr = lane & 15, g = lane >> 4;
    AttnTile<256> T[1]; T[0].init();
    const size_t row = (size_t)b * SEQ + qb * 128 + 16 * w + fr;
#pragma unroll
    for (int ds = 0; ds < 8; ++ds) T[0].q[ds] = ldq_scaled(p.QM + row * 1024 + head * 256 + 32 * ds + 8 * g, MEM_C);
    u32x4 rk[4], rv[4];
    auto ld = [&](int kb) {
#pragma unroll
        for (int i = 0; i < 4; ++i) { const int c = tid + 512 * i, key = c >> 5, ch = c & 31; const bf16_t* src = p.MKVp + (size_t)(b * MEMT + kb * 64 + key) * 2048 + head * 256 + ch * 8; rk[i] = *(const u32x4*)src; rv[i] = *(const u32x4*)(src + 1024); } };
    auto st = [&](LAS unsigned char* buf) {
#pragma unroll
        for (int i = 0; i < 4; ++i) { const int c = tid + 512 * i, key = c >> 5, ch = c & 31; *(LAS u32x4*)(buf + ktile_byte<256>(key, ch * 8)) = rk[i]; *(LAS u32x4*)(buf + 32768 + key * vstride<256>() + ch * 16) = rv[i]; } };
    ld(0);
    __syncthreads();
    st(lds + X_KT);
    __syncthreads();
    for (int kb = 0; kb < 4; ++kb) {
        LAS unsigned char* buf = lds + X_KT + (kb & 1) * X_BUF;
        if (kb < 3) ld(kb + 1);
        attn_block1<256>(T[0], 0, buf, buf + 32768, MEM_C, false, [&](int, int) { return true; }, lane);
        if (kb < 3) st(lds + X_KT + ((kb + 1) & 1) * X_BUF);
        __syncthreads();
    }
    attn_store_bf16<256>(T[0], p.OM + row * 1024 + head * 256, lane);
}
__device__ __forceinline__ void xattn_unit_sample(const Params& p, int unit, LAS unsigned char* lds) {
    const int b = unit >> 2, head = unit & 3;
    const int tid = TID(), lane = tid & 63, w = tid >> 6, fr = lane & 15, g = lane >> 4;
    AttnTile<256> T[1]; T[0].init();
    const size_t row = (size_t)MP + b * 8 + (fr & 7);
#pragma unroll
    for (int ds = 0; ds < 8; ++ds) T[0].q[ds] = ldq_scaled(p.QM + row * 1024 + head * 256 + 32 * ds + 8 * g, MEM_C);
    u32x4 rk[4], rv[4];
    auto ld = [&](int kb) {
#pragma unroll
        for (int i = 0; i < 4; ++i) { const int c = tid + 512 * i, key = c >> 5, ch = c & 31; const float* src = p.cache_mem + (size_t)(b * MEMT + kb * 64 + key) * 2048 + head * 256 + ch * 8;
            rk[i] = pack8(*(const f32x4*)src, *(const f32x4*)(src + 4)); rv[i] = pack8(*(const f32x4*)(src + 1024), *(const f32x4*)(src + 1028)); } };
    auto st = [&](LAS unsigned char* buf) {
#pragma unroll
        for (int i = 0; i < 4; ++i) { const int c = tid + 512 * i, key = c >> 5, ch = c & 31; *(LAS u32x4*)(buf + ktile_byte<256>(key, ch * 8)) = rk[i]; *(LAS u32x4*)(buf + 32768 + key * vstride<256>() + ch * 16) = rv[i]; } };
    ld(0);
    __syncthreads();
    st(lds + X_KT);
    __syncthreads();
    for (int kb = 0; kb < 4; ++kb) {
        LAS unsigned char* buf = lds + X_KT + (kb & 1) * X_BUF;
        if (w == 0) attn_block1<256>(T[0], 0, buf, buf + 32768, MEM_C, false, [&](int, int) { return true; }, lane);
        else if (kb < 3) { ld(kb + 1); st(lds + X_KT + ((kb + 1) & 1) * X_BUF); }
        if (w == 0 && kb < 3) { ld(kb + 1); st(lds + X_KT + ((kb + 1) & 1) * X_BUF); }
        __syncthreads();
    }
    if (w == 0) {
        const int gg = lane >> 4; const float inv = 1.0f / fmaxf(xsum16_32(T[0].l), 1e-30f);
        if (fr < 8) {
#pragma unroll
            for (int dt = 0; dt < 16; ++dt) { u32x2 wv; wv.x = cvt_pk_bf16(T[0].o[dt][0] * inv, T[0].o[dt][1] * inv); wv.y = cvt_pk_bf16(T[0].o[dt][2] * inv, T[0].o[dt][3] * inv);
                *(u32x2*)(p.OM + row * 1024 + head * 256 + 16 * dt + 4 * gg) = wv; }
        }
    }
}

__device__ __forceinline__ void row_stats(const float* st, int row, float& mean, float& rstd) {
    const f32x2 s = *(const f32x2*)(st + (size_t)row * 2); mean = s.x * (1.0f / 1024.0f); const float var = fmaxf(s.y * (1.0f / 1024.0f) - mean * mean, 0.f); rstd = rsqrtf(var + LN_EPS);
}
struct EpiRes {
    static constexpr bool PERM = true, AFTER_DRAIN = false;
    int mode; const float* xp; const float* xs; const float* zprev; const float* stprev; const float* gain; const float* bias; float* Z; bf16_t* Zb; float* st;
    __device__ __forceinline__ void apply8(int row, int col, float mean, float rstd, const f32x4 a0, const f32x4 a1, float& s1, float& s2) const {
        const float* __restrict__ rsrc = (mode == 0) ? (row < MP ? xp + (size_t)row * 1024 : xs + (size_t)(row - MP) * 1024) : zprev + (size_t)row * 1024;
        const float* __restrict__ gn = gain; const float* __restrict__ bs = bias; float* __restrict__ Zo = Z; bf16_t* __restrict__ Zbo = Zb;
        f32x4 x0 = *(const f32x4*)(rsrc + col), x1 = *(const f32x4*)(rsrc + col + 4);
        if (mode == 1) { const f32x4 g0 = *(const f32x4*)(gn + col), g1 = *(const f32x4*)(gn + col + 4), b0 = *(const f32x4*)(bs + col), b1 = *(const f32x4*)(bs + col + 4);
            x0 = (x0 - mean) * rstd * g0 + b0; x1 = (x1 - mean) * rstd * g1 + b1; }
        const f32x4 z0 = x0 * DN_ALPHA + a0, z1 = x1 * DN_ALPHA + a1;
        float* d = Zo + (size_t)row * 1024 + col; *(f32x4*)d = z0; *(f32x4*)(d + 4) = z1;
        if (Zbo) *(u32x4*)(Zbo + (size_t)row * 1024 + col) = pack8(z0, z1);
#pragma unroll
        for (int j = 0; j < 4; ++j) { s1 += z0[j] + z1[j]; s2 += z0[j] * z0[j] + z1[j] * z1[j]; }
    }
    __device__ __forceinline__ void operator()(const f32x4 (&acc)[2][2][4][2], const pg8::Unit& u, int wr, int wc, int fr, int fq) const {
        float mean8[2][4], rstd8[2][4];
#pragma unroll
        for (int ai = 0; ai < 2; ++ai)
#pragma unroll
            for (int m = 0; m < 4; ++m) { mean8[ai][m] = 0.f; rstd8[ai][m] = 1.f; if (mode == 1) row_stats(stprev, u.pm * 256 + ai * 128 + wr * 64 + m * 16 + fr, mean8[ai][m], rstd8[ai][m]); }
#pragma unroll
        for (int ai = 0; ai < 2; ++ai)
#pragma unroll
            for (int m = 0; m < 4; ++m) {
                const int row = u.pm * 256 + ai * 128 + wr * 64 + m * 16 + fr;
                const float mean = mean8[ai][m], rstd = rstd8[ai][m];
                float s1 = 0.f, s2 = 0.f;
#pragma unroll
                for (int bj = 0; bj < 2; ++bj) apply8(row, u.pn * 256 + bj * 128 + wc * 32 + 8 * fq, mean, rstd, acc[ai][bj][m][0], acc[ai][bj][m][1], s1, s2);
                s1 = xsum16_32(s1); s2 = xsum16_32(s2);
                if (fq == 0) { atomicAdd(st + (size_t)row * 2, s1); atomicAdd(st + (size_t)row * 2 + 1, s2); }
            }
    }
    __device__ __forceinline__ void small(int row, int col, const f32x4 a0, const f32x4 a1, int t) const {
        float mean = 0.f, rstd = 1.f; if (mode == 1) row_stats(stprev, row, mean, rstd);
        float s1 = 0.f, s2 = 0.f; apply8(row, col, mean, rstd, a0, a1, s1, s2);
        s1 += __shfl_xor(s1, 1); s1 += __shfl_xor(s1, 2); s1 += __shfl_xor(s1, 4); s2 += __shfl_xor(s2, 1); s2 += __shfl_xor(s2, 2); s2 += __shfl_xor(s2, 4);
        if ((t & 7) == 0) { atomicAdd(st + (size_t)row * 2, s1); atomicAdd(st + (size_t)row * 2 + 1, s2); }
    }
};
struct EpiLnIn {
    static constexpr bool PERM = true, AFTER_DRAIN = false;
    int act; const float* st; const float* cs; const float* bw; bf16_t* O; int ldo;
    __device__ __forceinline__ void apply8(int row, int col, float mean, float rstd, const f32x4 a0, const f32x4 a1) const {
        const f32x4 c0 = *(const f32x4*)(cs + col), c1 = *(const f32x4*)(cs + col + 4), b0 = *(const f32x4*)(bw + col), b1 = *(const f32x4*)(bw + col + 4);
        f32x4 y0 = (a0 - c0 * mean) * rstd + b0, y1 = (a1 - c1 * mean) * rstd + b1;
        if (act == 1) {
#pragma unroll
            for (int j = 0; j < 4; ++j) { const float a = fmaxf(y0[j], 0.f), b2 = fmaxf(y1[j], 0.f); y0[j] = a * a; y1[j] = b2 * b2; } }
        *(u32x4*)(O + (size_t)row * ldo + col) = pack8(y0, y1);
    }
    __device__ __forceinline__ void operator()(const f32x4 (&acc)[2][2][4][2], const pg8::Unit& u, int wr, int wc, int fr, int fq) const {
#pragma unroll
        for (int ai = 0; ai < 2; ++ai)
#pragma unroll
            for (int m = 0; m < 4; ++m) {
                const int row = u.pm * 256 + ai * 128 + wr * 64 + m * 16 + fr;
                float mean, rstd; row_stats(st, row, mean, rstd);
#pragma unroll
                for (int bj = 0; bj < 2; ++bj) apply8(row, u.pn * 256 + bj * 128 + wc * 32 + 8 * fq, mean, rstd, acc[ai][bj][m][0], acc[ai][bj][m][1]);
            }
    }
    __device__ __forceinline__ void small(int row, int col, const f32x4 a0, const f32x4 a1, int) const { float mean, rstd; row_stats(st, row, mean, rstd); apply8(row, col, mean, rstd, a0, a1); }
};
template <class Epi> __device__ __forceinline__ void small_gemm(LAS unsigned char* lds, const bf16_t* A, int lda, const bf16_t* Bt, int K, int rowbase, int nrt, int nct, const Epi& E) {
    const int tid = TID(), lane = tid & 63, w = tid >> 6, fr = lane & 15, g = lane >> 4;
    LAS float* red = (LAS float*)lds;
    const int kw = K >> 3;
    for (int tile = blockIdx.x; tile < nrt * nct; tile += gridDim.x) {
        const int row0 = rowbase + (tile / nct) * 64, col0 = (tile % nct) * 64;
        f32x4 acc[4][4];
#pragma unroll
        for (int mt = 0; mt < 4; ++mt)
#pragma unroll
            for (int nt = 0; nt < 4; ++nt) acc[mt][nt] = (f32x4){0.f, 0.f, 0.f, 0.f};
        const bf16_t* ap = A + (size_t)(row0 + fr) * lda + (size_t)w * kw + 8 * g;
        const bf16_t* bp = Bt + (size_t)(col0 + fr) * K + (size_t)w * kw + 8 * g;
        bf16x8 af[4][4], bfr[4][4];
#pragma unroll
        for (int st = 0; st < 4; ++st)
#pragma unroll
            for (int mt = 0; mt < 4; ++mt) { af[st][mt] = *(const bf16x8*)(ap + (size_t)(16 * mt) * lda + 32 * st); bfr[st][mt] = *(const bf16x8*)(bp + (size_t)(16 * mt) * K + 32 * st); }
        for (int k0 = 0; k0 < kw; k0 += 128) {
#pragma unroll
            for (int st = 0; st < 4; ++st) {
#pragma unroll
                for (int mt = 0; mt < 4; ++mt)
#pragma unroll
                    for (int nt = 0; nt < 4; ++nt) acc[mt][nt] = __builtin_amdgcn_mfma_f32_16x16x32_bf16(bfr[st][nt], af[st][mt], acc[mt][nt], 0, 0, 0);
                if (k0 + 128 < kw) {
#pragma unroll
                    for (int mt = 0; mt < 4; ++mt) { af[st][mt] = *(const bf16x8*)(ap + (size_t)(16 * mt) * lda + k0 + 128 + 32 * st); bfr[st][mt] = *(const bf16x8*)(bp + (size_t)(16 * mt) * K + k0 + 128 + 32 * st); }
                }
            }
        }
        __syncthreads();
#pragma unroll
        for (int mt = 0; mt < 4; ++mt)
#pragma unroll
            for (int nt = 0; nt < 4; ++nt) *(LAS f32x4*)(red + ((size_t)w * 64 + 16 * mt + fr) * 68 + 16 * nt + 4 * g) = acc[mt][nt];
        __syncthreads();
        {
            const int r = tid >> 3, c8 = (tid & 7) * 8;
            f32x4 s0 = (f32x4){0.f, 0.f, 0.f, 0.f}, s1 = s0;
#pragma unroll
            for (int ww = 0; ww < 8; ++ww) { const LAS float* q = red + ((size_t)ww * 64 + r) * 68 + c8; s0 += *(const LAS f32x4*)q; s1 += *(const LAS f32x4*)(q + 4); }
            E.small(row0 + r, col0 + c8, s0, s1, tid);
        }
    }
    __syncthreads();
}
template <class Epi> __device__ __forceinline__ void run_gemm(LAS unsigned char* lds, const bf16_t* A, int lda, const bf16_t* Bt, int M, int N, int K, const Epi& E) {
    pg8::Gemm g{A, Bt, M, N, K, lda};
    pg8::StaticOrder S; S.init(M, N, gridDim.x, blockIdx.x);
    pg8::gemm_phase<Epi, pg8::StaticOrder, false>(lds, g, S, E, nullptr);
}
__device__ __forceinline__ void phase_gemm1_small(const Params& p, LAS unsigned char* lds) {
    Epi1Small E0{0, &p};
    small_gemm(lds, p.Xb, DM, p.Wt_in + (size_t)26 * 256 * 1024, DM, 0, MT / 64, 1, E0);
    Epi1Small E1{1, &p};
    small_gemm(lds, p.Xb, DM, p.Wt_in + (size_t)33 * 256 * 1024, DM, MP, MS / 64, 512 / 64, E1);
}
__device__ __forceinline__ void final_ln(const Params& p) {
    const int lane = TID() & 63, gw = blockIdx.x * 8 + (TID() >> 6), nw = gridDim.x * 8;
    const float* gain = p.ln_g + 2048; const float* bias = p.ln_b + 2048;
    f32x4 g4[4], b4[4];
#pragma unroll
    for (int i = 0; i < 4; ++i) { const int c = (i * 64 + lane) * 4; g4[i] = *(const f32x4*)(gain + c); b4[i] = *(const f32x4*)(bias + c); }
    for (int row0 = gw; row0 < MT; row0 += 4 * nw) {
        f32x4 v[4][4]; float mean[4], rstd[4];
#pragma unroll
        for (int u = 0; u < 4; ++u) { const int row = row0 + u * nw; if (row < MT) { row_stats(p.stats3, row, mean[u], rstd[u]); const float* z = p.out + (size_t)row * 1024;
#pragma unroll
            for (int i = 0; i < 4; ++i) v[u][i] = *(const f32x4*)(z + (i * 64 + lane) * 4); } }
#pragma unroll
        for (int u = 0; u < 4; ++u) { const int row = row0 + u * nw; if (row < MT) { float* z = p.out + (size_t)row * 1024;
#pragma unroll
            for (int i = 0; i < 4; ++i) *(f32x4*)(z + (i * 64 + lane) * 4) = (v[u][i] - mean[u]) * rstd[u] * g4[i] + b4[i]; } }
    }
}

__device__ __forceinline__ int balanced_unit(int L) { const int i = L / (int)gridDim.x, q = L & 127; return (L & ~127) | ((i & 1) ? 127 - q : q); }
__device__ __forceinline__ void phase_mix1(const Params& p, LAS unsigned char* lds) {
    const bool sfirst = (blockIdx.x & 1) != 0;
    phase_gemm1_small(p, lds);
    {
        EpiPlain E{p.out + OFF_PMEM, 2048, p.MKVp, 2048};
        small_gemm(lds, p.Memb, DM, p.Wt_mkv, DM, 0, NBATCH * MEMT / 64, 2048 / 64, E);
    }
    {
        if (sfirst) for (int u = blockIdx.x; u < 512; u += gridDim.x) cmp_gemm_sample_unit(p, u, lds);
        EpiCmp E{(bf16_t*)p.CCp};
        small_gemm(lds, p.CKp, 1024, p.W1t, 1024, 0, 4096 / 64, 256 / 64, E);
        EpiCmp E2{(bf16_t*)p.CCp + (size_t)69632 * 256};
        small_gemm(lds, p.CVp, 1024, p.W1t + (size_t)256 * 1024, 1024, 0, 4096 / 64, 256 / 64, E2);
    }
    if (sfirst) { for (int u = blockIdx.x; u < 512; u += gridDim.x) win_unit_sample(p, u, lds); hgrn_sample_tasks(p, lds); }
    for (int u = blockIdx.x; u < 1024; u += gridDim.x) win_unit_prompt(p, u, lds);
    for (int t = blockIdx.x; t < 512; t += gridDim.x) hgrn_task<false>(p, t, lds);
    if (!sfirst) { for (int u = blockIdx.x; u < 512; u += gridDim.x) cmp_gemm_sample_unit(p, u, lds);
        for (int u = blockIdx.x; u < 512; u += gridDim.x) win_unit_sample(p, u, lds); hgrn_sample_tasks(p, lds); }
}
__device__ __forceinline__ void phase_mix2(const Params& p, LAS unsigned char* lds) { hgrn_scan(p); cmp_stage2(p); }
__device__ __forceinline__ void phase_mix3(const Params& p, LAS unsigned char* lds) {
    for (int t = blockIdx.x; t < 512; t += gridDim.x) hgrn_task<true>(p, t, lds);
    for (int u = blockIdx.x; u < 1024; u += gridDim.x) cmp_unit(p, false, balanced_unit(u), lds);
    for (int u = blockIdx.x; u < 512; u += gridDim.x) cmp_unit(p, true, u, lds);
}
__device__ __forceinline__ void phase_slc(const Params& p, LAS unsigned char* lds) {
    const int c = blockIdx.x, G = gridDim.x; const bool sfirst = (c & 1) != 0;
    if (sfirst) for (int u = c; u < 512; u += G) slc_unit_sample(p, u, lds);
    if (G == 256) { const int bkv = c & 7, m = c >> 3;
        for (int i = 0; i < 4; ++i) { const int qt = (i == 0) ? m : (i == 1) ? 63 - m : (i == 2) ? 64 + m : 127 - m; slc_unit_prompt_ring(p, bkv * 128 + qt, lds); } }
    else for (int u = c; u < 1024; u += G) slc_unit_prompt_ring(p, balanced_unit(u), lds);
    if (!sfirst) for (int u = c; u < 512; u += G) slc_unit_sample(p, u, lds);
}
__device__ __forceinline__ void phase_wout(const Params& p, LAS unsigned char* lds) {
    EpiRes E{0, p.x_prompt, p.x_sample, nullptr, nullptr, nullptr, nullptr, p.Z1, p.Z1b, p.stats1};
    run_gemm(lds, p.MERGED, DM, p.Wt_out, MP, DM, DM, E);
    small_gemm(lds, p.MERGED, DM, p.Wt_out, DM, MP, MS / 64, DM / 64, E);
}
__device__ __forceinline__ void phase_mq(const Params& p, LAS unsigned char* lds) {
    EpiLnIn E{0, p.stats1, p.cs_mq, p.bw_mq, p.QM, 1024};
    run_gemm(lds, p.Z1b, DM, p.Wt_mq, MP, DM, DM, E);
    small_gemm(lds, p.Z1b, DM, p.Wt_mq, DM, MP, MS / 64, DM / 64, E);
}
__device__ __forceinline__ void phase_xattn(const Params& p, LAS unsigned char* lds) {
    if (blockIdx.x & 1) for (int u = blockIdx.x; u < 512; u += gridDim.x) xattn_unit_sample(p, u, lds);
    for (int u = blockIdx.x; u < 512; u += gridDim.x) xattn_unit_prompt(p, u, lds);
    if (!(blockIdx.x & 1)) for (int u = blockIdx.x; u < 512; u += gridDim.x) xattn_unit_sample(p, u, lds);
}
__device__ __forceinline__ void phase_mo(const Params& p, LAS unsigned char* lds) {
    EpiRes E{1, nullptr, nullptr, p.Z1, p.stats1, p.ln_g, p.ln_b, p.Z2, p.Z2b, p.stats2};
    run_gemm(lds, p.OM, DM, p.Wt_mo, MP, DM, DM, E);
    small_gemm(lds, p.OM, DM, p.Wt_mo, DM, MP, MS / 64, DM / 64, E);
}
__device__ __forceinline__ void phase_up(const Params& p, LAS unsigned char* lds) {
    EpiLnIn E{1, p.stats2, p.cs_up, p.bw_up, p.Hb, DFF};
    run_gemm(lds, p.Z2b, DM, p.Wt_up, MP, DFF, DM, E);
    small_gemm(lds, p.Z2b, DM, p.Wt_up, DM, MP, MS / 64, DFF / 64, E);
}
__device__ __forceinline__ void phase_down(const Params& p, LAS unsigned char* lds) {
    EpiRes E{1, nullptr, nullptr, p.Z2, p.stats2, p.ln_g + 1024, p.ln_b + 1024, p.out, nullptr, p.stats3};
    run_gemm(lds, p.Hb, DFF, p.Wt_down, MP, DM, DFF, E);
    small_gemm(lds, p.Hb, DFF, p.Wt_down, DFF, MP, MS / 64, DM / 64, E);
}
constexpr int LDS_BYTES = 160 * 1024;
constexpr int NTHREADS = 512;

template <int PH> __device__ __forceinline__ void run_phase(const Params& p, LAS unsigned char* lds) {
    if constexpr (PH == 0) phase_prologue(p, lds);
    else if constexpr (PH == 1) phase_gemm1(p, lds);
    else if constexpr (PH == 2) phase_mix1(p, lds);
    else if constexpr (PH == 3) phase_mix2(p, lds);
    else if constexpr (PH == 4) phase_mix3(p, lds);
    else if constexpr (PH == 5) phase_slc(p, lds);
    else if constexpr (PH == 6) phase_wout(p, lds);
    else if constexpr (PH == 7) phase_mq(p, lds);
    else if constexpr (PH == 8) phase_xattn(p, lds);
    else if constexpr (PH == 9) phase_mo(p, lds);
    else if constexpr (PH == 10) phase_up(p, lds);
    else if constexpr (PH == 11) phase_down(p, lds);
    else if constexpr (PH == 12) final_ln(p);
}

template <int PH> __global__ void __launch_bounds__(NTHREADS, 2) k_phase(Params p) {
    extern __shared__ __attribute__((aligned(16))) unsigned char smem[];
    run_phase<PH>(p, (LAS unsigned char*)smem);
}


__global__ void __launch_bounds__(NTHREADS, 2) k_mega(Params p) {
    extern __shared__ __attribute__((aligned(16))) unsigned char smem[];
    LAS unsigned char* lds = (LAS unsigned char*)smem;
    volatile LAS unsigned* xbw = (volatile LAS unsigned*)(lds + LDS_BYTES - 16);
    if (TID() == 0) { xbw[0] = 0u; xbw[1] = 0u; }
    __syncthreads();
    XcdBarrier bar = xcd_barrier_post(p.bar, xbw);
    run_phase<0>(p, lds);  xcd_barrier(bar);
    run_phase<1>(p, lds);  xcd_barrier(bar);
    run_phase<2>(p, lds);  xcd_barrier(bar);
    run_phase<3>(p, lds);  xcd_barrier(bar);
    run_phase<4>(p, lds);  xcd_barrier(bar);
    run_phase<5>(p, lds);  xcd_barrier(bar);
    run_phase<6>(p, lds);  xcd_barrier(bar);
    run_phase<7>(p, lds);  xcd_barrier(bar);
    run_phase<8>(p, lds);  xcd_barrier(bar);
    run_phase<9>(p, lds);  xcd_barrier(bar);
    run_phase<10>(p, lds); xcd_barrier(bar);
    run_phase<11>(p, lds); xcd_barrier(bar);
    run_phase<12>(p, lds);
}

struct WsAlloc { char* base; size_t off; template <class T> T* get(size_t n) { T* r = (T*)(base + off); off += (n * sizeof(T) + 255) & ~(size_t)255; return r; } };

template <int PH> static void launch_phase(const Params& p, hipStream_t stream) {
    static bool attr = false;
    if (!attr) { (void)hipFuncSetAttribute((const void*)k_phase<PH>, hipFuncAttributeMaxDynamicSharedMemorySize, LDS_BYTES); attr = true; }
    hipLaunchKernelGGL(k_phase<PH>, dim3(256), dim3(NTHREADS), LDS_BYTES, stream, p);
}

extern "C" void kernel_launch(void* const* d_in, const int* in_sizes, int n_in, void* d_out, int out_size, void* d_ws, size_t ws_size, hipStream_t stream) {
    Params p{};
    p.x_prompt = (const float*)d_in[0]; p.x_sample = (const float*)d_in[1]; p.state_hgrn = (const float*)d_in[2]; p.cache_cmp = (const float*)d_in[3];
    p.cache_slc = (const float*)d_in[4]; p.cache_win = (const float*)d_in[5]; p.cache_mem = (const float*)d_in[6]; p.page_table = (const int*)d_in[7];
    p.mem_prompt = (const float*)d_in[8]; p.w_in = (const float*)d_in[9]; p.w_out = (const float*)d_in[10]; p.hg_lb = (const float*)d_in[11];
    p.hg_gnorm = (const float*)d_in[12]; p.cmp_pe = (const float*)d_in[13]; p.cmp_w1 = (const float*)d_in[14]; p.cmp_w2 = (const float*)d_in[15];
    p.w_mq = (const float*)d_in[16]; p.w_mkv = (const float*)d_in[17]; p.w_mo = (const float*)d_in[18]; p.w_up = (const float*)d_in[19];
    p.w_down = (const float*)d_in[20]; p.ln_g = (const float*)d_in[21]; p.ln_b = (const float*)d_in[22];
    p.out = (float*)d_out;
    WsAlloc W{(char*)d_ws, 0};
    p.bar = W.get<unsigned>(4096); p.stats1 = W.get<float>((size_t)MT * 2); p.stats2 = W.get<float>((size_t)MT * 2); p.stats3 = W.get<float>((size_t)MT * 2);
    p.cs_mq = W.get<float>(1024); p.bw_mq = W.get<float>(1024); p.cs_up = W.get<float>(4096); p.bw_up = W.get<float>(4096); p.posb = W.get<float>(256);
    const size_t zero_bytes = W.off;
    p.Wt_in = W.get<bf16_t>((size_t)NINP * DM); p.Wt_out = W.get<bf16_t>((size_t)DM * DM); p.Wt_mq = W.get<bf16_t>((size_t)DM * DM); p.Wt_mkv = W.get<bf16_t>((size_t)2 * DM * DM);
    p.Wt_mo = W.get<bf16_t>((size_t)DM * DM); p.Wt_up = W.get<bf16_t>((size_t)DFF * DM); p.Wt_down = W.get<bf16_t>((size_t)DM * DFF);
    p.W1t = W.get<bf16_t>((size_t)2 * 256 * 1024); p.W2t = W.get<bf16_t>((size_t)2 * 64 * 128);
    p.lbv = W.get<float>(1024); p.rope = W.get<float>((size_t)SEQ * 64);
    p.Xb = W.get<bf16_t>((size_t)MT * DM); p.Memb = W.get<bf16_t>((size_t)NBATCH * MEMT * DM);
    p.HQ = W.get<bf16_t>((size_t)MT * DM); p.HV = W.get<bf16_t>((size_t)MT * DM); p.HOG = W.get<bf16_t>((size_t)MT * DM); p.QN = W.get<bf16_t>((size_t)MT * DM);
    p.QR = W.get<bf16_t>((size_t)MT * DM); p.GA = W.get<bf16_t>((size_t)MT * DM); p.GB = W.get<bf16_t>((size_t)MT * DM);
    p.G = W.get<float>((size_t)MT * DM); p.NG = W.get<float>((size_t)MT * 48);
    p.CKp = W.get<bf16_t>((size_t)4 * MP * 64); p.CKs = W.get<bf16_t>((size_t)4 * DBATCH * PAST * 64);
    p.CVp = W.get<bf16_t>((size_t)4 * MP * 64); p.CVs = W.get<bf16_t>((size_t)4 * DBATCH * PAST * 64);
    p.SKp = W.get<bf16_t>((size_t)4 * MP * 64); p.SVp = W.get<bf16_t>((size_t)4 * MP * 64); p.WKp = W.get<bf16_t>((size_t)4 * MP * 64); p.WVp = W.get<bf16_t>((size_t)4 * MP * 64);
    p.SKs = W.get<bf16_t>((size_t)4 * MS * 64); p.SVs = W.get<bf16_t>((size_t)4 * MS * 64); p.WKs = W.get<bf16_t>((size_t)4 * MS * 64); p.WVs = W.get<bf16_t>((size_t)4 * MS * 64);
    p.MKVp = W.get<bf16_t>((size_t)NBATCH * MEMT * 2048);
    p.CCp = W.get<float>((size_t)2 * 4096 * 256); p.CCs = W.get<float>((size_t)2 * 65536 * 256);
    p.KCp = W.get<bf16_t>((size_t)NBATCH * 4 * 512 * 64); p.VCp = W.get<bf16_t>((size_t)NBATCH * 4 * 512 * 64);
    p.KCs = W.get<bf16_t>((size_t)DBATCH * 4 * 128 * 64); p.VCs = W.get<bf16_t>((size_t)DBATCH * 4 * 128 * 64);
    p.Lloc = W.get<float>((size_t)512 * 128 * 128); p.Dec = W.get<float>((size_t)512 * 128); p.Sst = W.get<bf16_t>((size_t)512 * 128 * 128);
    p.OHG = W.get<bf16_t>((size_t)MT * DM); p.OWIN = W.get<bf16_t>((size_t)MT * DM); p.OCMP = W.get<bf16_t>((size_t)MT * DM); p.MERGED = W.get<bf16_t>((size_t)MT * DM);
    p.SEL = W.get<unsigned>((size_t)MT * 16);
    p.Z1 = W.get<float>((size_t)MT * DM); p.Z2 = W.get<float>((size_t)MT * DM); p.Z1b = W.get<bf16_t>((size_t)MT * DM); p.Z2b = W.get<bf16_t>((size_t)MT * DM);
    p.QM = W.get<bf16_t>((size_t)MT * DM); p.OM = W.get<bf16_t>((size_t)MT * DM); p.Hb = W.get<bf16_t>((size_t)MT * DFF);
    if (W.off > ws_size) { fprintf(stderr, "workspace too small: need %zu have %zu\n", W.off, ws_size); return; }
    (void)hipMemsetAsync(d_ws, 0, zero_bytes, stream);
#if defined(MK_MULTI)
    launch_phase<0>(p, stream); launch_phase<1>(p, stream); launch_phase<2>(p, stream); launch_phase<3>(p, stream); launch_phase<4>(p, stream);
    launch_phase<5>(p, stream); launch_phase<6>(p, stream); launch_phase<7>(p, stream); launch_phase<8>(p, stream); launch_phase<9>(p, stream);
    launch_phase<10>(p, stream); launch_phase<11>(p, stream); launch_phase<12>(p, stream);
#else
    static int grid = 0;
    if (!grid) {
        int dev = 0, cus = 0, per_cu = 0;
        (void)hipGetDevice(&dev); (void)hipDeviceGetAttribute(&cus, hipDeviceAttributeMultiprocessorCount, dev);
        (void)hipFuncSetAttribute((const void*)k_mega, hipFuncAttributeMaxDynamicSharedMemorySize, LDS_BYTES);
        (void)hipOccupancyMaxActiveBlocksPerMultiprocessor(&per_cu, (const void*)k_mega, NTHREADS, LDS_BYTES);
        if (per_cu < 1) { fprintf(stderr, "k_mega does not fit on a CU\n"); return; }
        grid = cus;
    }
    hipLaunchKernelGGL(k_mega, dim3(grid), dim3(NTHREADS), LDS_BYTES, stream, p);
#endif
}
```

```cpp
#include <hip/hip_runtime.h>
#include <stdint.h>
#include <stdio.h>

#define LAS __attribute__((address_space(3)))
typedef unsigned short bf16_t;
typedef short bf16x8 __attribute__((ext_vector_type(8)));
typedef short bf16x4 __attribute__((ext_vector_type(4)));
typedef float f32x4 __attribute__((ext_vector_type(4)));
typedef float f32x2 __attribute__((ext_vector_type(2)));
typedef unsigned u32x4 __attribute__((ext_vector_type(4)));
typedef unsigned u32x2 __attribute__((ext_vector_type(2)));

constexpr int DM = 1024, SEQ = 8192, NBATCH = 2, MP = NBATCH * SEQ, DBATCH = 128, DSEQ = 8, MS = DBATCH * DSEQ, MT = MP + MS;
constexpr int PAST = 2048, PAGE = 128, NPAGES = PAST / PAGE, WIN = 512, MEMT = 256;
constexpr int NIN = 8752, NINP = 8960, DFF = 4096;
constexpr int NCMP_P = SEQ / 16 - 1  , NCMP_S = PAST / 16 - 1  ;
constexpr float LN_EPS = 1e-5f, RMS_EPS = 1e-6f;
constexpr float DN_ALPHA = 1.18920711500272f;
constexpr size_t OFF_Y = 0, OFF_PSTATE = 17825792, OFF_PCMP = 18087936, OFF_PSLC = 26476544, OFF_PWIN = 34865152, OFF_PMEM = 35389440,
                 OFF_SSTATE = 36438016, OFF_SCMP = 53215232, OFF_SSLC = 53739520, OFF_SWIN = 54263808;

__device__ __forceinline__ float bf2f(bf16_t v) { return __uint_as_float((unsigned)v << 16); }
typedef __bf16 bf16x2_t __attribute__((ext_vector_type(2)));
__device__ __forceinline__ unsigned cvt_pk_bf16(float lo, float hi) { const f32x2 v = {lo, hi}; return __builtin_bit_cast(unsigned, __builtin_convertvector(v, bf16x2_t)); }
__device__ __forceinline__ bf16_t f2bf(float f) { return (bf16_t)(cvt_pk_bf16(f, 0.f) & 0xffffu); }
__device__ __forceinline__ float fast_exp(float x) { return __builtin_amdgcn_exp2f(x * 1.44269504088896f); }
__device__ __forceinline__ float sigmoidf_(float x) { return __builtin_amdgcn_rcpf(1.0f + fast_exp(-x)); }
__device__ __forceinline__ float siluf_(float x) { return x * sigmoidf_(x); }
__device__ __forceinline__ float lo_bf(unsigned w) { return __uint_as_float(w << 16); }
__device__ __forceinline__ float hi_bf(unsigned w) { return __uint_as_float(w & 0xffff0000u); }
__device__ __forceinline__ u32x4 pack8(const f32x4 a, const f32x4 b) { u32x4 o; o.x = cvt_pk_bf16(a[0], a[1]); o.y = cvt_pk_bf16(a[2], a[3]); o.z = cvt_pk_bf16(b[0], b[1]); o.w = cvt_pk_bf16(b[2], b[3]); return o; }
__device__ __forceinline__ int TID() { int t = threadIdx.x; asm volatile("" : "+v"(t)); return t; }
namespace pg8 {
#define PG8_LAS __attribute__((address_space(3)))
typedef unsigned short bf16_t;
typedef short bf16x8 __attribute__((ext_vector_type(8)));
typedef float f32x4 __attribute__((ext_vector_type(4)));
typedef unsigned u32x4 __attribute__((ext_vector_type(4)));
constexpr int BM = 256, BK = 64, HALF = 128, HTB = HALF * BK * 2  , STAGE_BYTES = 8 * HTB, NXCD = 8, WGM = 8;

__host__ __device__ __forceinline__ int lds_byte(int r, int c) { const int st = (r >> 4) * 2 + (c >> 5), rr = r & 15, cc = c & 31, ob = rr * 64 + cc * 2; return st * 1024 + (ob ^ (((ob >> 9) & 1) << 5)); }
__host__ __device__ __forceinline__ void stage_rc(int b, int& R, int& C) { const int st = b / 1024, sb = b % 1024, swz = sb ^ (((sb >> 9) & 1) << 5); R = (st >> 1) * 16 + swz / 64; C = (st & 1) * 32 + (swz % 64) / 2; }
__host__ __device__ __forceinline__ int perm32(int rho) { const int n = rho >> 4, i = rho & 15; return 8 * (i >> 2) + 4 * n + (i & 3); }

struct Unit { int pm, pn; };
struct Gemm { const bf16_t* A; const bf16_t* Bt; int M, N, K, lda; };
struct StaticOrder {
    int nM, nN, nwg, G, c;
    __host__ __device__ void init(int M, int N, int G_, int c_) { nM = M / BM; nN = N / BM; nwg = nM * nN; G = G_; c = c_; }
    __host__ __device__ bool next(int i, Unit& u) const {
        const long L = (long)i * G + c; if (L >= nwg) return false;
        int wgid = (int)L; { const int q = nwg / NXCD, r = nwg % NXCD, xcd = wgid % NXCD, off = wgid / NXCD; wgid = (xcd < r ? xcd * (q + 1) : r * (q + 1) + (xcd - r) * q) + off; }
        const int nig = WGM * nN, gid = wgid / nig, fm = gid * WGM, gsz = (nM - fm) < WGM ? (nM - fm) : WGM;
        u.pm = fm + ((wgid % nig) % gsz); u.pn = (wgid % nig) / gsz; return true;
    }
    __device__ __forceinline__ void a_ready(const Unit&) const {}
    __device__ __forceinline__ void done(const Unit&) const {}
};
template <class Epi, class Sched, bool STAMP = false>
__device__ __forceinline__ void gemm_phase(PG8_LAS unsigned char* lds, const Gemm g, const Sched& S, const Epi& E, unsigned long long* stamps) {
    const int tid = TID(), wid = __builtin_amdgcn_readfirstlane(tid >> 6), lane = tid & 63, wr = wid >> 2, wc = wid & 3, fr = lane & 15, fq = lane >> 4;
    const int K = g.K, nt = K / BK;
    int ts_lo = 0, ts_hi = 0, nts = 0; const unsigned long long rt_entry = STAMP ? (unsigned long long)wall_clock64() : 0ull;
#define PG8_STAMP() do { if (STAMP && wid == 0 && nts < 64) { const unsigned long long _c = (unsigned long long)clock64(); \
        ts_lo = (lane == nts) ? (int)(unsigned)_c : ts_lo; ts_hi = (lane == nts) ? (int)(unsigned)(_c >> 32) : ts_hi; ++nts; } } while (0)
    PG8_STAMP();
    unsigned voffA[2], voffB[2];
#pragma unroll
    for (int i = 0; i < 2; ++i) { int R, C; stage_rc(tid * 16 + i * 8192, R, C); const int Rb = Epi::PERM ? ((R & ~31) + perm32(R & 31)) : R;
        voffA[i] = (unsigned)(R * g.lda + C) * 2u; voffB[i] = (unsigned)(Rb * K + C) * 2u; }
    const size_t kstep = (size_t)(BK * 2);
    const size_t hstep = (size_t)HALF * K * 2, hstepA = (size_t)HALF * g.lda * 2;
    const size_t tstep = 2 * hstep, tstepA = 2 * hstepA;
    const unsigned ldsw = (unsigned)wid * 1024u;
    const int aoff = lds_byte(wr * 64 + fr, fq * 8), boff = lds_byte(wc * 32 + fr, fq * 8);
#define PG8_SA(b, h) (((b) * 2 + (h)) * HTB)
#define PG8_SB(b, h) ((4 + (b) * 2 + (h)) * HTB)
#define PG8_STAGE(bufoff, gbase, voff) do { _Pragma("unroll") for (int _i = 0; _i < 2; ++_i) \
        __builtin_amdgcn_global_load_lds((const unsigned*)((const char*)(gbase) + (voff)[_i]), (PG8_LAS unsigned*)(lds + (bufoff) + ldsw + _i * 8192), 16, 0, 0); } while (0)
#define PG8_LDA(dst, b, h) do { _Pragma("unroll") for (int m = 0; m < 4; ++m) _Pragma("unroll") for (int k = 0; k < 2; ++k) dst[m][k] = *(const PG8_LAS bf16x8*)(lds + PG8_SA(b, h) + aoff + m * 2048 + k * 1024); } while (0)
#define PG8_LDB(dst, b, h) do { _Pragma("unroll") for (int n = 0; n < 2; ++n) _Pragma("unroll") for (int k = 0; k < 2; ++k) dst[n][k] = *(const PG8_LAS bf16x8*)(lds + PG8_SB(b, h) + boff + n * 2048 + k * 1024); } while (0)
#define PG8_MMA(ai, bj, At, Bt) do { __builtin_amdgcn_s_setprio(1); _Pragma("unroll") for (int m = 0; m < 4; ++m) _Pragma("unroll") for (int n = 0; n < 2; ++n) _Pragma("unroll") for (int k = 0; k < 2; ++k) \
        acc[ai][bj][m][n] = __builtin_amdgcn_mfma_f32_16x16x32_bf16(Bt[n][k], At[m][k], acc[ai][bj][m][n], 0, 0, 0); __builtin_amdgcn_s_setprio(0); } while (0)
#define PG8_WAIT_V(n) asm volatile("s_waitcnt vmcnt(" #n ")" ::: "memory")
#define PG8_WAIT_L(n) asm volatile("s_waitcnt lgkmcnt(" #n ")" ::: "memory")
#define PG8_BAR __builtin_amdgcn_s_barrier()
#define PG8_SCHED __builtin_amdgcn_sched_barrier(0)
    Unit cur, nxt; int ui = 0;
    if (!S.next(0, cur)) return;
    f32x4 acc[2][2][4][2];
#pragma unroll
    for (int a = 0; a < 2; ++a)
#pragma unroll
        for (int b = 0; b < 2; ++b)
#pragma unroll
            for (int m = 0; m < 4; ++m)
#pragma unroll
                for (int n = 0; n < 2; ++n) acc[a][b][m][n] = (f32x4){0.f, 0.f, 0.f, 0.f};
    bf16x8 At[4][2], B0[2][2], B1[2][2];
    const char* cA = (const char*)g.A + (size_t)cur.pm * tstepA; const char* cB = (const char*)g.Bt + (size_t)cur.pn * tstep;
    S.a_ready(cur);
    PG8_STAGE(PG8_SB(0, 0), cB, voffB); PG8_STAGE(PG8_SA(0, 0), cA, voffA); PG8_STAGE(PG8_SB(0, 1), cB + hstep, voffB); PG8_STAGE(PG8_SA(0, 1), cA + hstepA, voffA);
    if (wr == 1) PG8_BAR;
    PG8_WAIT_V(4); PG8_BAR;
    PG8_STAGE(PG8_SB(1, 0), cB + kstep, voffB); PG8_STAGE(PG8_SA(1, 0), cA + kstep, voffA); PG8_STAGE(PG8_SB(1, 1), cB + hstep + kstep, voffB);
    PG8_WAIT_V(6); PG8_BAR;
    PG8_STAMP();
    for (;;) {
        const bool has_next = S.next(ui + 1, nxt);
        const char* nA = has_next ? (const char*)g.A + (size_t)nxt.pm * tstepA : cA; const char* nB = has_next ? (const char*)g.Bt + (size_t)nxt.pn * tstep : cB;
        for (int t = 0; t < nt; t += 2) {
            const bool last = (t == nt - 2);
            const char* a1 = cA + (size_t)(t + 1) * kstep;
            const char* a2 = last ? nA : cA + (size_t)(t + 2) * kstep; const char* b2 = last ? nB : cB + (size_t)(t + 2) * kstep;
            const char* a3 = a2 + kstep; const char* b3 = b2 + kstep;
            if (last && has_next) S.a_ready(nxt);
            PG8_LDB(B0, 0, 0); PG8_SCHED; PG8_LDA(At, 0, 0); PG8_STAGE(PG8_SA(1, 1), a1 + hstepA, voffA);
            PG8_WAIT_L(8); PG8_BAR; PG8_WAIT_L(0); PG8_MMA(0, 0, At, B0); PG8_BAR; PG8_SCHED;
            PG8_LDB(B1, 0, 1); PG8_STAGE(PG8_SB(0, 0), b2, voffB);
            PG8_BAR; PG8_WAIT_L(0); PG8_MMA(0, 1, At, B1); PG8_BAR;
            PG8_LDA(At, 0, 1); PG8_STAGE(PG8_SA(0, 0), a2, voffA);
            PG8_BAR; PG8_WAIT_L(0); PG8_MMA(1, 0, At, B0); PG8_BAR; PG8_SCHED;
            PG8_STAGE(PG8_SB(0, 1), b2 + hstep, voffB);
            PG8_WAIT_V(6); PG8_BAR; PG8_MMA(1, 1, At, B1); PG8_BAR;
            PG8_LDB(B0, 1, 0); PG8_SCHED; PG8_LDA(At, 1, 0); PG8_STAGE(PG8_SA(0, 1), a2 + hstepA, voffA);
            PG8_WAIT_L(8); PG8_BAR; PG8_WAIT_L(0); PG8_MMA(0, 0, At, B0); PG8_BAR; PG8_SCHED;
            PG8_LDB(B1, 1, 1); PG8_STAGE(PG8_SB(1, 0), b3, voffB);
            PG8_BAR; PG8_WAIT_L(0); PG8_MMA(0, 1, At, B1); PG8_BAR;
            PG8_LDA(At, 1, 1); PG8_STAGE(PG8_SA(1, 0), a3, voffA);
            PG8_BAR; PG8_WAIT_L(0); PG8_MMA(1, 0, At, B0); PG8_BAR; PG8_SCHED;
            PG8_STAGE(PG8_SB(1, 1), b3 + hstep, voffB);
            PG8_WAIT_V(6); PG8_BAR; PG8_MMA(1, 1, At, B1); PG8_BAR;
        }
        PG8_STAMP();
        if constexpr (!Epi::AFTER_DRAIN) { E(acc, cur, wr, wc, fr, fq); S.done(cur); }
        PG8_STAMP();
        if (!has_next) break;
#pragma unroll
        for (int a = 0; a < 2; ++a)
#pragma unroll
            for (int b = 0; b < 2; ++b)
#pragma unroll
                for (int m = 0; m < 4; ++m)
#pragma unroll
                    for (int n = 0; n < 2; ++n) acc[a][b][m][n] = (f32x4){0.f, 0.f, 0.f, 0.f};
        cur = nxt; cA = nA; cB = nB; ++ui;
    }
    PG8_WAIT_V(0);
    if (wr == 0) PG8_BAR;
    PG8_BAR;
    if constexpr (Epi::AFTER_DRAIN) { E.fused(acc, cur, wr, wc, fr, fq, lds, wid, lane); S.done(cur); }
    PG8_STAMP();
    if (STAMP && wid == 0) { stamps[lane] = lane < nts ? (((unsigned long long)(unsigned)ts_hi << 32) | (unsigned)ts_lo) : 0ull;
        if (lane == 62) stamps[62] = rt_entry; if (lane == 63) stamps[63] = (unsigned long long)wall_clock64(); }
#undef PG8_STAMP
#undef PG8_SA
#undef PG8_SB
#undef PG8_STAGE
#undef PG8_LDA
#undef PG8_LDB
#undef PG8_MMA
#undef PG8_WAIT_V
#undef PG8_WAIT_L
#undef PG8_BAR
#undef PG8_SCHED
}
}
#define XB_TMO      128
#define XB_XCNT(j)  (256  + 64 * (j))
#define XB_XSUB(j)  (1280 + 64 * (j))
#define XB_XGEN(j)  (2304 + 64 * (j))
#define XB_TOP      3328
#define XB_TOPGEN   3392
#define XCD_BAR_WORDS 3456
#define XB_SPIN_CAP (1u << 18)

__device__ __forceinline__ unsigned xb_ld(unsigned* p)              { return __hip_atomic_load(p, __ATOMIC_RELAXED, __HIP_MEMORY_SCOPE_AGENT); }
__device__ __forceinline__ unsigned xb_add(unsigned* p, unsigned v) { return __hip_atomic_fetch_add(p, v, __ATOMIC_RELAXED, __HIP_MEMORY_SCOPE_AGENT); }
__device__ __forceinline__ unsigned xb_xcc_id() { return (unsigned)__builtin_amdgcn_s_getreg((3 << 11) | 20) & 0xFu; }
#define XB_SPIN(cond, bar) do { unsigned _sp = 0; while (cond) { __builtin_amdgcn_s_sleep(1); \
    if ((++_sp & 255u) == 0u) { if (xb_ld(&(bar)[XB_TMO])) break; if (_sp > XB_SPIN_CAP) { atomicAdd(&(bar)[XB_TMO], 1u); break; } } } } while (0)

struct XcdBarrier {
    unsigned* bar; unsigned x;
    volatile LAS unsigned* st;
};

__device__ __forceinline__ XcdBarrier xcd_barrier_post(unsigned* bar, volatile LAS unsigned* st) {
    XcdBarrier b; b.bar = bar; b.x = xb_xcc_id(); b.st = st;
    if (threadIdx.x == 0) (void)xb_add(&bar[XB_XCNT(b.x)], 1u);
    return b;
}
__device__ __forceinline__ void xcd_barrier_complete(unsigned* bar, unsigned x, unsigned& nloc, unsigned& nx) {
    const unsigned G = gridDim.x * gridDim.y * gridDim.z;
    unsigned sum, cnt, mine, sp = 0u;
    for (;;) {
        sum = 0u; cnt = 0u; mine = 0u;
#pragma unroll
        for (unsigned j = 0; j < 16; ++j) { const unsigned c = xb_ld(&bar[XB_XCNT(j)]); sum += c; cnt += (c > 0u) ? 1u : 0u; mine = (j == x) ? c : mine; }
        if (sum == G) break;
        __builtin_amdgcn_s_sleep(1);
        if ((++sp & 255u) == 0u) { if (xb_ld(&bar[XB_TMO])) break; if (sp > XB_SPIN_CAP) { atomicAdd(&bar[XB_TMO], 1u); break; } }
    }
    nloc = mine > 0u ? mine : 1u; nx = cnt > 0u ? cnt : 1u;
}

__device__ __forceinline__ void xcd_barrier(const XcdBarrier& b) {
    asm volatile("s_waitcnt vmcnt(0)" ::: "memory");
    __syncthreads();
    if (threadIdx.x == 0) {
        unsigned* bar = b.bar;
        __builtin_amdgcn_s_waitcnt(0);
        unsigned nloc = b.st[0], nx = b.st[1];
        if (nloc == 0u) { xcd_barrier_complete(bar, b.x, nloc, nx); b.st[0] = nloc; b.st[1] = nx; }
        const unsigned old = xb_add(&bar[XB_XSUB(b.x)], 1u);
        const unsigned gen = old / nloc;
        if (old + 1u == (gen + 1u) * nloc) {
            __builtin_amdgcn_fence(__ATOMIC_RELEASE, "agent");
            asm volatile("s_waitcnt vmcnt(0)" ::: "memory");
            const unsigned og = xb_add(&bar[XB_TOP], 1u);
            const unsigned tg = og / nx;
            if (og + 1u == (tg + 1u) * nx) xb_add(&bar[XB_TOPGEN], 1u);
            else XB_SPIN(xb_ld(&bar[XB_TOPGEN]) == tg, bar);
            __builtin_amdgcn_fence(__ATOMIC_ACQUIRE, "agent");
            xb_add(&bar[XB_XGEN(b.x)], 1u);
            asm volatile("s_waitcnt vmcnt(0)" ::: "memory");
        } else {
            XB_SPIN(xb_ld(&bar[XB_XGEN(b.x)]) == gen, bar);
            __builtin_amdgcn_fence(__ATOMIC_ACQUIRE, "agent");
            asm volatile("s_waitcnt vmcnt(0)" ::: "memory");
        }
    }
    __syncthreads();
}

struct Params {
    const float *x_prompt, *x_sample, *state_hgrn, *cache_cmp, *cache_slc, *cache_win, *cache_mem;
    const int* page_table;
    const float *mem_prompt, *w_in, *w_out, *hg_lb, *hg_gnorm, *cmp_pe, *cmp_w1, *cmp_w2, *w_mq, *w_mkv, *w_mo, *w_up, *w_down, *ln_g, *ln_b;
    float* out;
    unsigned* bar; float *stats1, *stats2, *stats3, *cs_mq, *bw_mq, *cs_up, *bw_up, *posb;
    bf16_t *Wt_in, *Wt_out, *Wt_mq, *Wt_mkv, *Wt_mo, *Wt_up, *Wt_down, *W1t, *W2t;
    float *lbv, *rope;
    bf16_t *Xb, *Memb, *HQ, *HV, *HOG, *QN, *QR, *GA, *GB;
    float *G, *NG;
    bf16_t *CKp, *CVp, *CKs, *CVs, *SKp, *SVp, *WKp, *WVp, *SKs, *SVs, *WKs, *WVs, *MKVp;
    float *CCp, *CCs;
    bf16_t *KCp, *VCp, *KCs, *VCs;
    float *Lloc, *Dec; bf16_t* Sst;
    bf16_t *OHG, *OWIN, *OCMP, *MERGED;
    unsigned* SEL;
    float *Z1, *Z2; bf16_t *Z1b, *Z2b, *QM, *OM, *Hb;
};
__device__ __forceinline__ int ilv64(int c) { return (c & ~63) | (((c & 63) >> 1) + 32 * (c & 1)); }
__device__ __forceinline__ int win_src_col(int n) {
    const int tn = n >> 8, cl = n & 255;
    if (tn < 16) return n;
    if (tn < 20) return 4096 + (tn - 16) * 256 + ilv64(cl);
    if (tn < 26) { const int base = 5120 + (tn - 20) * 256; return base + ((tn == 22 || tn == 24) ? ilv64(cl) : cl); }
    if (tn == 26) return cl < 48 ? 6656 + cl : -1;
    if (tn < 31) return 6704 + (tn - 27) * 256 + cl;
    return 7728 + (tn - 31) * 256 + cl;
}

template <int W> __device__ __forceinline__ void transpose_tile(const Params& p, int id, int nt, int kt, LAS float* tile  ) {
    const float* src; bf16_t* dst; int K, ldsrc; const float* gain = nullptr; const float* bias = nullptr; float* cs = nullptr; float* bw = nullptr; int map = 0;
    switch (id) {
        case 0: src = p.w_in; dst = p.Wt_in; K = 1024; ldsrc = NIN; map = 1; break;
        case 1: src = p.w_out; dst = p.Wt_out; K = 1024; ldsrc = 1024; break;
        case 2: src = p.w_mq; dst = p.Wt_mq; K = 1024; ldsrc = 1024; gain = p.ln_g; bias = p.ln_b; cs = p.cs_mq; bw = p.bw_mq; break;
        case 3: src = p.w_mkv; dst = p.Wt_mkv; K = 1024; ldsrc = 2048; break;
        case 4: src = p.w_mo; dst = p.Wt_mo; K = 1024; ldsrc = 1024; break;
        case 5: src = p.w_up; dst = p.Wt_up; K = 1024; ldsrc = 4096; gain = p.ln_g + 1024; bias = p.ln_b + 1024; cs = p.cs_up; bw = p.bw_up; break;
        case 6: src = p.w_down; dst = p.Wt_down; K = 4096; ldsrc = 1024; break;
        case 7: case 8: case 9: case 10: { const int sel = (id - 7) >> 1, half = (id - 7) & 1; src = p.cmp_w1 + (size_t)(sel * 2048 + half * 1024) * 128; dst = p.W1t + (size_t)(sel * 256 + half * 128) * 1024; K = 1024; ldsrc = 128; break; }
        default: { const int sel = id - 11; src = p.cmp_w2 + (size_t)sel * 128 * 64; dst = p.W2t + (size_t)sel * 64 * 128; K = 128; ldsrc = 64; map = (sel == 0) ? 2 : 0; break; }
    }
    constexpr int NR = 64 * W / 512;
    const int t = TID(), n0 = nt * W, k0 = kt * 64;
    {
        const int nn = t & (W - 1); int sc = n0 + nn;
        if (map == 1) sc = win_src_col(sc); else if (map == 2) sc = ilv64(sc);
        float v[NR];
#pragma unroll
        for (int rr = 0; rr < NR; ++rr) { const int kk = t / W + (512 / W) * rr; v[rr] = (sc >= 0) ? src[(size_t)(k0 + kk) * ldsrc + sc] : 0.f; }
#pragma unroll
        for (int rr = 0; rr < NR; ++rr) { const int kk = t / W + (512 / W) * rr; tile[kk * (W + 1) + nn] = v[rr]; }
    }
    __syncthreads();
#pragma unroll
    for (int it = 0; it < W / 64; ++it) {
        const int c = t + 512 * it, nn = c >> 3, kc = (c & 7) * 8;
        float w[8];
#pragma unroll
        for (int j = 0; j < 8; ++j) { float x = tile[(kc + j) * (W + 1) + nn]; if (gain) x *= gain[k0 + kc + j]; w[j] = x; }
        u32x4 o; o.x = cvt_pk_bf16(w[0], w[1]); o.y = cvt_pk_bf16(w[2], w[3]); o.z = cvt_pk_bf16(w[4], w[5]); o.w = cvt_pk_bf16(w[6], w[7]);
        *(u32x4*)(dst + (size_t)(n0 + nn) * K + k0 + kc) = o;
        if (cs) {
            float s1 = lo_bf(o.x) + hi_bf(o.x) + lo_bf(o.y) + hi_bf(o.y) + lo_bf(o.z) + hi_bf(o.z) + lo_bf(o.w) + hi_bf(o.w);
            float s2 = 0.f;
#pragma unroll
            for (int j = 0; j < 8; ++j) s2 += bias[k0 + kc + j] * tile[(kc + j) * (W + 1) + nn];
            s1 += __shfl_xor(s1, 1); s1 += __shfl_xor(s1, 2); s1 += __shfl_xor(s1, 4);
            s2 += __shfl_xor(s2, 1); s2 += __shfl_xor(s2, 2); s2 += __shfl_xor(s2, 4);
            if ((t & 7) == 0) { atomicAdd(cs + n0 + nn, s1); atomicAdd(bw + n0 + nn, s2); }
        }
    }
    __syncthreads();
}

__device__ __forceinline__ void prologue_transposes2(const Params& p, LAS unsigned char* lds) {
    LAS float* tile = (LAS float*)lds;
    const int G = gridDim.x, wg = blockIdx.x;
    constexpr int NJ1 = 128, NJ2 = 128, NJ4 = 128, NJ5 = 512, NJ6 = 512, TOT = NJ1 + NJ2 + NJ4 + NJ5 + NJ6;
    for (int j = wg; j < TOT; j += G) {
        int id, r = j, nkt = 16;
        if (r < NJ1) id = 1;
        else if ((r -= NJ1) < NJ2) id = 2;
        else if ((r -= NJ2) < NJ4) id = 4;
        else if ((r -= NJ4) < NJ5) id = 5;
        else { r -= NJ5; id = 6; nkt = 64; }
        transpose_tile<128>(p, id, r / nkt, r % nkt, tile);
    }
}
__device__ __forceinline__ void phase_prologue(const Params& p, LAS unsigned char* lds) {
    LAS float* tile = (LAS float*)lds;
    const int t = TID(), G = gridDim.x, wg = blockIdx.x;
    constexpr int NJ0 = 70 * 16, NJ3 = 256, NJ7 = 32, NJ11 = 2;
    constexpr int TOT = NJ0 + NJ3 + 4 * NJ7 + 2 * NJ11;
    for (int j = wg; j < TOT; j += G) {
        int r = j;
        if (r < NJ0) transpose_tile<128>(p, 0, r / 16, r % 16, tile);
        else if ((r -= NJ0) < NJ3) transpose_tile<128>(p, 3, r / 16, r % 16, tile);
        else if ((r -= NJ3) < 4 * NJ7) { const int id = 7 + r / NJ7; r %= NJ7; transpose_tile<64>(p, id, r / 16, r % 16, tile); }
        else { r -= 4 * NJ7; const int id = 11 + r / NJ11; r %= NJ11; transpose_tile<64>(p, id, r / 2, r % 2, tile); }
    }
    prologue_transposes2(p, lds);
    {
        const size_t nx = (size_t)MT * DM / 8, nm = (size_t)NBATCH * MEMT * DM / 8, stride = (size_t)G * 512;
        for (size_t i0 = (size_t)wg * 512 + t; i0 < nx + nm; i0 += 4 * stride) {
            f32x4 a[4], b[4];
#pragma unroll
            for (int u = 0; u < 4; ++u) { const size_t i = i0 + u * stride; if (i < nx + nm) { const float* s;
                if (i < nx) { const size_t e = i * 8; s = (e < (size_t)MP * DM) ? p.x_prompt + e : p.x_sample + (e - (size_t)MP * DM); } else s = p.mem_prompt + (i - nx) * 8;
                a[u] = *(const f32x4*)s; b[u] = *(const f32x4*)(s + 4); } }
#pragma unroll
            for (int u = 0; u < 4; ++u) { const size_t i = i0 + u * stride; if (i < nx + nm) { bf16_t* d = (i < nx) ? p.Xb + i * 8 : p.Memb + (i - nx) * 8; *(u32x4*)d = pack8(a[u], b[u]); } }
        }
    }
    for (int i = wg * 512 + t; i < SEQ * 32; i += G * 512) {
        const int pos = i >> 5, fi = i & 31;
        const float inv = powf(10000.0f, -(float)fi / 32.0f);
        const float ang = (float)pos * inv;
        double rev = (double)ang * 0.15915494309189535; rev -= floor(rev);
        const float fr = (float)rev;
        p.rope[2 * i] = __builtin_amdgcn_cosf(fr); p.rope[2 * i + 1] = __builtin_amdgcn_sinf(fr);
    }
    for (int i = wg * 512 + t; i < 1024; i += G * 512) {
        const float a = p.hg_lb[i], b = p.hg_lb[1024 + i], m = fmaxf(a, b), ea = expf(a - m), eb = expf(b - m);
        p.lbv[i] = ea / (ea + eb);
    }
    for (int j = wg; j < 64; j += G) {
        const int sel = j >> 5, l = j & 31, h = t & 127, part = t >> 7;
        float s = 0.f;
        for (int d = part * 16; d < part * 16 + 16; ++d) s += p.cmp_pe[(sel * 32 + l) * 64 + d] * p.cmp_w1[((size_t)(sel * 32 + l) * 64 + d) * 128 + h];
        atomicAdd(p.posb + sel * 128 + h, s);
    }
}
#define EPI_FOR_FRAGS(...) \
    _Pragma("unroll") for (int ai = 0; ai < 2; ++ai) _Pragma("unroll") for (int m = 0; m < 4; ++m) _Pragma("unroll") for (int bj = 0; bj < 2; ++bj) { \
        const int row = u.pm * 256 + ai * 128 + wr * 64 + m * 16 + fr, cl = bj * 128 + wc * 32 + 8 * fq; \
        const f32x4 v0 = acc[ai][bj][m][0], v1 = acc[ai][bj][m][1]; (void)row; (void)cl; __VA_ARGS__ }


struct Epi1 {
    static constexpr bool PERM = true, AFTER_DRAIN = false;
    const Params* pp;
    __device__ __forceinline__ void operator()(const f32x4 (&acc)[2][2][4][2], const pg8::Unit& u, int wr, int wc, int fr, int fq) const {
        const Params& p = *pp;
        const int pn = u.pn;
        const float* __restrict__ ropeT = p.rope; const float* __restrict__ lbT = p.lbv;
        if (pn < 4 || (pn >= 12 && pn < 16)) {
            bf16_t* dst = (pn < 4) ? p.HQ + pn * 256 : p.HOG + (pn - 12) * 256;
            EPI_FOR_FRAGS({ f32x4 a, b; for (int j = 0; j < 4; ++j) { a[j] = siluf_(v0[j]); b[j] = siluf_(v1[j]); } *(u32x4*)(dst + (size_t)row * 1024 + cl) = pack8(a, b); })
        } else if (pn < 8) {
            const int c0 = (pn - 4) * 256;
            EPI_FOR_FRAGS({ const f32x4 l0 = *(const f32x4*)(lbT + c0 + cl), l1 = *(const f32x4*)(lbT + c0 + cl + 4); f32x4 a, b;
                for (int j = 0; j < 4; ++j) { a[j] = __logf(l0[j] + (1.f - l0[j]) * sigmoidf_(v0[j])); b[j] = __logf(l1[j] + (1.f - l1[j]) * sigmoidf_(v1[j])); }
                float* d = p.G + (size_t)row * 1024 + c0 + cl; *(f32x4*)d = a; *(f32x4*)(d + 4) = b; })
        } else if (pn < 12) {
            bf16_t* dst = p.HV + (pn - 8) * 256;
            EPI_FOR_FRAGS({ *(u32x4*)(dst + (size_t)row * 1024 + cl) = pack8(v0, v1); })
        } else if (pn < 20) {
            const int c0 = (pn - 16) * 256;
            EPI_FOR_FRAGS({ const int pos = row < MP ? (row & (SEQ - 1)) : PAST + ((row - MP) & 7);
                const f32x4 r0 = *(const f32x4*)(ropeT + ((size_t)pos * 32 + ((cl & 63) >> 1)) * 2), r1 = *(const f32x4*)(ropeT + ((size_t)pos * 32 + ((cl & 63) >> 1)) * 2 + 4);
                *(u32x4*)(p.QN + (size_t)row * 1024 + c0 + cl) = pack8(v0, v1);
                f32x4 a, b;
                a[0] = v0[0] * r0[0] - v0[1] * r0[1]; a[1] = v0[1] * r0[0] + v0[0] * r0[1]; a[2] = v0[2] * r0[2] - v0[3] * r0[3]; a[3] = v0[3] * r0[2] + v0[2] * r0[3];
                b[0] = v1[0] * r1[0] - v1[1] * r1[1]; b[1] = v1[1] * r1[0] + v1[0] * r1[1]; b[2] = v1[2] * r1[2] - v1[3] * r1[3]; b[3] = v1[3] * r1[2] + v1[2] * r1[3];
                *(u32x4*)(p.QR + (size_t)row * 1024 + c0 + cl) = pack8(a, b); })
        } else if (pn < 26) {
            const int br = (pn - 20) >> 1, sel = (pn - 20) & 1;
            EPI_FOR_FRAGS({
                const bool isp = row < MP; const int rs = row - MP, b = isp ? (row >> 13) : (rs >> 3), tt = isp ? (row & (SEQ - 1)) : (rs & 7);
                const int kv = cl >> 6, c6 = cl & 63;
                float* o = nullptr;
                if (br == 0) o = isp ? p.out + OFF_PCMP + (size_t)row * 512 : p.out + OFF_SCMP + (size_t)rs * 512;
                else if (br == 1) o = isp ? p.out + OFF_PSLC + (size_t)row * 512 : p.out + OFF_SSLC + (size_t)rs * 512;
                else { if (isp) { if (tt >= SEQ - WIN) o = p.out + OFF_PWIN + (size_t)(b * WIN + tt - (SEQ - WIN)) * 512; } else o = p.out + OFF_SWIN + (size_t)(b * WIN + (WIN - DSEQ) + tt) * 512; }
                bf16_t* cp;
                if (br == 0) cp = isp ? (sel ? p.CVp : p.CKp) + ((size_t)kv * MP + row) * 64 : nullptr;
                else if (br == 1) cp = isp ? (sel ? p.SVp : p.SKp) + ((size_t)kv * MP + row) * 64 : (sel ? p.SVs : p.SKs) + ((size_t)kv * MS + rs) * 64;
                else cp = isp ? (sel ? p.WVp : p.WKp) + ((size_t)kv * MP + row) * 64 : (sel ? p.WVs : p.WKs) + ((size_t)kv * MS + rs) * 64;
                if (sel == 1 || br == 0) {
                    if (o) { float* d = o + sel * 256 + cl; *(f32x4*)d = v0; *(f32x4*)(d + 4) = v1; }
                    if (cp) *(u32x4*)(cp + c6) = pack8(v0, v1);
                } else {
                    const int pos = isp ? tt : PAST + tt, i0 = c6 >> 1;
                    const f32x4 r0 = *(const f32x4*)(ropeT + ((size_t)pos * 32 + i0) * 2), r1 = *(const f32x4*)(ropeT + ((size_t)pos * 32 + i0) * 2 + 4);
                    f32x4 lo, hi;
                    lo[0] = v0[0] * r0[0] - v0[1] * r0[1]; hi[0] = v0[1] * r0[0] + v0[0] * r0[1]; lo[1] = v0[2] * r0[2] - v0[3] * r0[3]; hi[1] = v0[3] * r0[2] + v0[2] * r0[3];
                    lo[2] = v1[0] * r1[0] - v1[1] * r1[1]; hi[2] = v1[1] * r1[0] + v1[0] * r1[1]; lo[3] = v1[2] * r1[2] - v1[3] * r1[3]; hi[3] = v1[3] * r1[2] + v1[2] * r1[3];
                    if (o) { float* d = o + kv * 64 + i0; *(f32x4*)d = lo; *(f32x4*)(d + 32) = hi; }
                    if (cp) { u32x4 w; w.x = cvt_pk_bf16(lo[0], hi[0]); w.y = cvt_pk_bf16(lo[1], hi[1]); w.z = cvt_pk_bf16(lo[2], hi[2]); w.w = cvt_pk_bf16(lo[3], hi[3]); *(u32x4*)(cp + c6) = w; }
                } })
        } else if (pn == 26) {
            EPI_FOR_FRAGS({ if (cl < 48) { f32x4 a, b; for (int j = 0; j < 4; ++j) { a[j] = sigmoidf_(v0[j]); b[j] = sigmoidf_(v1[j]); } float* d = p.NG + (size_t)row * 48 + cl; *(f32x4*)d = a; *(f32x4*)(d + 4) = b; } })
        } else {
            bf16_t* dst = (pn < 31) ? p.GA + (pn - 27) * 256 : p.GB + (pn - 31) * 256;
            EPI_FOR_FRAGS({ f32x4 a, b; for (int j = 0; j < 4; ++j) { a[j] = sigmoidf_(v0[j]); b[j] = sigmoidf_(v1[j]); } *(u32x4*)(dst + (size_t)row * 1024 + cl) = pack8(a, b); })
        }
    }
};

struct EpiPlain {
    static constexpr bool PERM = true, AFTER_DRAIN = false;
    float* C; int ldc; bf16_t* Cb; int ldb;
    __device__ __forceinline__ void operator()(const f32x4 (&acc)[2][2][4][2], const pg8::Unit& u, int wr, int wc, int fr, int fq) const {
        EPI_FOR_FRAGS({ const int col = u.pn * 256 + cl;
            if (C) { float* d = C + (size_t)row * ldc + col; *(f32x4*)d = v0; *(f32x4*)(d + 4) = v1; }
            if (Cb) *(u32x4*)(Cb + (size_t)row * ldb + col) = pack8(v0, v1); })
    }
    __device__ __forceinline__ void small(int row, int col, const f32x4 a0, const f32x4 a1, int) const {
        if (C) { float* d = C + (size_t)row * ldc + col; *(f32x4*)d = a0; *(f32x4*)(d + 4) = a1; }
        if (Cb) *(u32x4*)(Cb + (size_t)row * ldb + col) = pack8(a0, a1);
    }
};

struct G1Order {
    pg8::StaticOrder so; int G, c;
    __device__ void init(int G_, int c_) { G = G_; c = c_; so.init(MP, 34 * 256, G_, c_); }
    __device__ bool next(int i, pg8::Unit& u) const {
        const int L = i * G + c;
        if (L < 64 * 34) { if (!so.next(i, u)) return false; u.pn = u.pn < 26 ? u.pn : u.pn + 1; return true; }
        const int L2 = L - 64 * 34; if (L2 >= 128) return false;
        u.pm = 64 + (L2 & 3); const int q = L2 >> 2; u.pn = q < 26 ? q : q + 1; return true;
    }
    __device__ __forceinline__ void a_ready(const pg8::Unit&) const {}
    __device__ __forceinline__ void done(const pg8::Unit&) const {}
};
struct Epi1Small {
    int kind; const Params* pp;
    __device__ __forceinline__ void small(int row, int col, const f32x4 a0, const f32x4 a1, int) const {
        const Params& p = *pp; f32x4 a, b;
#pragma unroll
        for (int j = 0; j < 4; ++j) { a[j] = sigmoidf_(a0[j]); b[j] = sigmoidf_(a1[j]); }
        if (kind == 0) { if (col < 48) { float* d = p.NG + (size_t)row * 48 + col; *(f32x4*)d = a; *(f32x4*)(d + 4) = b; } }
        else *(u32x4*)(p.GB + (size_t)row * 1024 + 512 + col) = pack8(a, b);
    }
};
__device__ __forceinline__ void phase_gemm1(const Params& p, LAS unsigned char* lds) {
    pg8::Gemm g{p.Xb, p.Wt_in, MT, NINP, DM, DM};
    G1Order S; S.init(gridDim.x, blockIdx.x);
    Epi1 E{&p};
    pg8::gemm_phase<Epi1, G1Order, false>(lds, g, S, E, nullptr);
}
template <int HD> __device__ __forceinline__ int ktile_byte(int key, int d) { const int st = (key >> 4) * (HD / 32) + (d >> 5), ob = (key & 15) * 64 + (d & 31) * 2; return st * 1024 + (ob ^ (((ob >> 9) & 1) << 5)); }
template <int HD> constexpr int vstride() { return HD * 2 + 32; }
template <int HD> constexpr int ktile_bytes() { return 64 * HD * 2; }
template <int HD> constexpr int vtile_bytes() { return 64 * vstride<HD>(); }
typedef short s16x4 __attribute__((ext_vector_type(4)));
constexpr float NEG_INF = -__builtin_huge_valf();

template <int HD> struct AttnTile {
    bf16x8 q[HD / 32];
    f32x4 o[HD / 16];
    float m, l;
    __device__ __forceinline__ void init() { m = NEG_INF; l = 0.f;
#pragma unroll
        for (int i = 0; i < HD / 16; ++i) o[i] = (f32x4){0.f, 0.f, 0.f, 0.f}; }
};

__device__ __forceinline__ bf16x8 ldq_scaled(const bf16_t* q, float c) {
    const u32x4 v = *(const u32x4*)q; u32x4 o;
    o.x = cvt_pk_bf16(lo_bf(v.x) * c, hi_bf(v.x) * c); o.y = cvt_pk_bf16(lo_bf(v.y) * c, hi_bf(v.y) * c); o.z = cvt_pk_bf16(lo_bf(v.z) * c, hi_bf(v.z) * c); o.w = cvt_pk_bf16(lo_bf(v.w) * c, hi_bf(v.w) * c);
    return __builtin_bit_cast(bf16x8, o);
}
template <int HD, int NT> __device__ __forceinline__ void attn_scores(f32x4 (&s)[NT][4], AttnTile<HD>* const (&T)[NT], const LAS unsigned char* Kt, int lane) {
    const int fr = lane & 15, g = lane >> 4;
#pragma unroll
    for (int kt = 0; kt < 4; ++kt) {
        bf16x8 kf[HD / 32];
#pragma unroll
        for (int ds = 0; ds < HD / 32; ++ds) kf[ds] = *(const LAS bf16x8*)(Kt + ktile_byte<HD>(16 * kt + fr, 32 * ds + 8 * g));
#pragma unroll
        for (int u = 0; u < NT; ++u) { f32x4 acc = (f32x4){0.f, 0.f, 0.f, 0.f};
#pragma unroll
            for (int ds = 0; ds < HD / 32; ++ds) acc = __builtin_amdgcn_mfma_f32_16x16x32_bf16(kf[ds], T[u]->q[ds], acc, 0, 0, 0);
            s[u][kt] = acc; }
    }
}
template <int HD, int NT> __device__ __forceinline__ void attn_pv(AttnTile<HD>* const (&T)[NT], const bf16x8 (&pf)[NT][2], const LAS unsigned char* Vt, int lane) {
    const int fr = lane & 15, g = lane >> 4;
    const LAS unsigned char* vb = Vt + (4 * g + (fr >> 2)) * vstride<HD>() + (fr & 3) * 8;
#pragma unroll
    for (int dt = 0; dt < HD / 16; ++dt) {
        bf16x8 vf[2];
#pragma unroll
        for (int ph = 0; ph < 2; ++ph) {
            const s16x4 a = __builtin_amdgcn_ds_read_tr16_b64_v4i16((LAS s16x4*)(vb + (32 * ph) * vstride<HD>() + dt * 32));
            const s16x4 b = __builtin_amdgcn_ds_read_tr16_b64_v4i16((LAS s16x4*)(vb + (32 * ph + 16) * vstride<HD>() + dt * 32));
            vf[ph] = (bf16x8){a[0], a[1], a[2], a[3], b[0], b[1], b[2], b[3]};
        }
#pragma unroll
        for (int u = 0; u < NT; ++u)
#pragma unroll
            for (int ph = 0; ph < 2; ++ph) T[u]->o[dt] = __builtin_amdgcn_mfma_f32_16x16x32_bf16(vf[ph], pf[u][ph], T[u]->o[dt], 0, 0, 0);
    }
}
__device__ __forceinline__ float xmax16_32(float v) {
    auto r = __builtin_amdgcn_permlane32_swap(__float_as_uint(v), __float_as_uint(v), false, false); v = fmaxf(__uint_as_float(r[0]), __uint_as_float(r[1]));
    auto q = __builtin_amdgcn_permlane16_swap(__float_as_uint(v), __float_as_uint(v), false, false); return fmaxf(__uint_as_float(q[0]), __uint_as_float(q[1]));
}
__device__ __forceinline__ float xsum16_32(float v) {
    auto r = __builtin_amdgcn_permlane32_swap(__float_as_uint(v), __float_as_uint(v), false, false); v = __uint_as_float(r[0]) + __uint_as_float(r[1]);
    auto q = __builtin_amdgcn_permlane16_swap(__float_as_uint(v), __float_as_uint(v), false, false); return __uint_as_float(q[0]) + __uint_as_float(q[1]);
}

template <int HD, int NT, bool UM, class RowF, class MaskF>
__device__ __forceinline__ void attn_block(AttnTile<HD>* const (&T)[NT], const LAS unsigned char* Kt, const LAS unsigned char* Vt, float c, RowF&& rowok, MaskF&& mask, int lane) {
    const int g = lane >> 4;
    f32x4 s[NT][4];
    attn_scores<HD, NT>(s, T, Kt, lane);
    bf16x8 pf[NT][2];
#pragma unroll
    for (int u = 0; u < NT; ++u) {
        if (UM) {
#pragma unroll
            for (int kt = 0; kt < 4; ++kt)
#pragma unroll
                for (int r = 0; r < 4; ++r) s[u][kt][r] = mask(u, 16 * kt + 4 * g + r) ? s[u][kt][r] : NEG_INF;
        }
        const bool ok = rowok(u);
        float mx = fmaxf(fmaxf(fmaxf(s[u][0][0], s[u][0][1]), fmaxf(s[u][0][2], s[u][0][3])), fmaxf(fmaxf(s[u][1][0], s[u][1][1]), fmaxf(s[u][1][2], s[u][1][3])));
        mx = fmaxf(mx, fmaxf(fmaxf(fmaxf(s[u][2][0], s[u][2][1]), fmaxf(s[u][2][2], s[u][2][3])), fmaxf(fmaxf(s[u][3][0], s[u][3][1]), fmaxf(s[u][3][2], s[u][3][3]))));
        mx = xmax16_32(ok ? mx : NEG_INF);
        const float mnew = fmaxf(T[u]->m, mx), msafe = (mnew == NEG_INF) ? 0.f : mnew;
        const float alpha = __builtin_amdgcn_exp2f(T[u]->m - msafe), mc = ok ? msafe : 3.0e38f;
        f32x4 ps4 = (f32x4){0.f, 0.f, 0.f, 0.f};
#pragma unroll
        for (int kt = 0; kt < 4; ++kt) { const f32x4 t = s[u][kt] - mc; f32x4 e; e[0] = __builtin_amdgcn_exp2f(t[0]); e[1] = __builtin_amdgcn_exp2f(t[1]); e[2] = __builtin_amdgcn_exp2f(t[2]); e[3] = __builtin_amdgcn_exp2f(t[3]); s[u][kt] = e; ps4 += e; }
        T[u]->l = T[u]->l * alpha + ((ps4[0] + ps4[1]) + (ps4[2] + ps4[3])); T[u]->m = mnew;
#pragma unroll
        for (int dt = 0; dt < HD / 16; ++dt) T[u]->o[dt] *= alpha;
#pragma unroll
        for (int ph = 0; ph < 2; ++ph) {
            u32x4 w; w.x = cvt_pk_bf16(s[u][2 * ph][0], s[u][2 * ph][1]); w.y = cvt_pk_bf16(s[u][2 * ph][2], s[u][2 * ph][3]);
            w.z = cvt_pk_bf16(s[u][2 * ph + 1][0], s[u][2 * ph + 1][1]); w.w = cvt_pk_bf16(s[u][2 * ph + 1][2], s[u][2 * ph + 1][3]);
            pf[u][ph] = __builtin_bit_cast(bf16x8, w);
        }
    }
    attn_pv<HD, NT>(T, pf, Vt, lane);
}
template <int HD, class MaskF> __device__ __forceinline__ void attn_block2(AttnTile<HD> (&T)[2], const LAS unsigned char* Kt, const LAS unsigned char* Vt, float c, bool use_mask, MaskF&& mask, int lane) {
    AttnTile<HD>* const tp[2] = {&T[0], &T[1]};
    if (use_mask) attn_block<HD, 2, true>(tp, Kt, Vt, c, [](int) { return true; }, mask, lane); else attn_block<HD, 2, false>(tp, Kt, Vt, c, [](int) { return true; }, mask, lane);
}
template <int HD, class MaskF> __device__ __forceinline__ void attn_block1(AttnTile<HD>& T, int u0, const LAS unsigned char* Kt, const LAS unsigned char* Vt, float c, bool use_mask, MaskF&& mask, int lane) {
    AttnTile<HD>* const tp[1] = {&T};
    if (use_mask) attn_block<HD, 1, true>(tp, Kt, Vt, c, [](int) { return true; }, [&](int, int kl) { return mask(u0, kl); }, lane); else attn_block<HD, 1, false>(tp, Kt, Vt, c, [](int) { return true; }, [&](int, int kl) { return mask(u0, kl); }, lane);
}
template <bool UM, class RowF, class MaskF> __device__ __forceinline__ void attn_block_sel_um(AttnTile<64> (&T)[2], bool a0, bool a1, const LAS unsigned char* Kt, const LAS unsigned char* Vt, float c, RowF&& rowok, MaskF&& mask, int lane) {
    if (a0 && a1) { AttnTile<64>* const tp[2] = {&T[0], &T[1]}; attn_block<64, 2, UM>(tp, Kt, Vt, c, rowok, mask, lane); }
    else if (a0) { AttnTile<64>* const tp[1] = {&T[0]}; attn_block<64, 1, UM>(tp, Kt, Vt, c, [&](int) { return rowok(0); }, [&](int, int kl) { return mask(0, kl); }, lane); }
    else if (a1) { AttnTile<64>* const tp[1] = {&T[1]}; attn_block<64, 1, UM>(tp, Kt, Vt, c, [&](int) { return rowok(1); }, [&](int, int kl) { return mask(1, kl); }, lane); }
}
template <class RowF, class MaskF> __device__ __forceinline__ void attn_block_sel(AttnTile<64> (&T)[2], bool a0, bool a1, const LAS unsigned char* Kt, const LAS unsigned char* Vt, float c, RowF&& rowok, bool use_mask, MaskF&& mask, int lane) {
    if (use_mask) attn_block_sel_um<true>(T, a0, a1, Kt, Vt, c, rowok, mask, lane); else attn_block_sel_um<false>(T, a0, a1, Kt, Vt, c, rowok, mask, lane);
}

__device__ __forceinline__ void stage_k64_bf16(LAS unsigned char* Kt, const bf16_t* src, int nvalid) {
    const int t = TID(), key = t >> 3, ch = t & 7;
    u32x4 v = (u32x4){0u, 0u, 0u, 0u}; if (key < nvalid) v = *(const u32x4*)(src + (size_t)key * 64 + ch * 8);
    *(LAS u32x4*)(Kt + ktile_byte<64>(key, ch * 8)) = v;
}
__device__ __forceinline__ void stage_v64_bf16(LAS unsigned char* Vt, const bf16_t* src, int nvalid) {
    const int t = TID(), key = t >> 3, ch = t & 7;
    u32x4 v = (u32x4){0u, 0u, 0u, 0u}; if (key < nvalid) v = *(const u32x4*)(src + (size_t)key * 64 + ch * 8);
    *(LAS u32x4*)(Vt + key * vstride<64>() + ch * 16) = v;
}
__device__ __forceinline__ void stage_k64_f32(LAS unsigned char* Kt, const float* src, size_t row_stride, int nvalid, float* copy, size_t copy_stride, int copy_from) {
    const int t = TID(), key = t >> 3, ch = t & 7;
    u32x4 v = (u32x4){0u, 0u, 0u, 0u};
    if (key < nvalid) { const float* s = src + (size_t)key * row_stride + ch * 4; const f32x4 a = *(const f32x4*)s, b = *(const f32x4*)(s + 32);
        v.x = cvt_pk_bf16(a[0], b[0]); v.y = cvt_pk_bf16(a[1], b[1]); v.z = cvt_pk_bf16(a[2], b[2]); v.w = cvt_pk_bf16(a[3], b[3]);
        if (copy && key >= copy_from) { float* d = copy + (size_t)key * copy_stride + ch * 4; *(f32x4*)d = a; *(f32x4*)(d + 32) = b; } }
    *(LAS u32x4*)(Kt + ktile_byte<64>(key, ch * 8)) = v;
}
__device__ __forceinline__ void stage_v64_f32(LAS unsigned char* Vt, const float* src, size_t row_stride, int nvalid, float* copy, size_t copy_stride, int copy_from) {
    const int t = TID(), key = t >> 3, ch = t & 7;
    u32x4 v = (u32x4){0u, 0u, 0u, 0u};
    if (key < nvalid) { const float* s = src + (size_t)key * row_stride + ch * 8; const f32x4 a = *(const f32x4*)s, b = *(const f32x4*)(s + 4);
        v = pack8(a, b);
        if (copy && key >= copy_from) { float* d = copy + (size_t)key * copy_stride + ch * 8; *(f32x4*)d = a; *(f32x4*)(d + 4) = b; } }
    *(LAS u32x4*)(Vt + key * vstride<64>() + ch * 16) = v;
}

__device__ __forceinline__ u32x4 ld_bf16_item(const bf16_t* src, int item, int nvalid) { const int key = item >> 3, ch = item & 7; return key < nvalid ? *(const u32x4*)(src + (size_t)key * 64 + ch * 8) : (u32x4){0u, 0u, 0u, 0u}; }
__device__ __forceinline__ void st_k_item(LAS unsigned char* Kt, int item, u32x4 v) { *(LAS u32x4*)(Kt + ktile_byte<64>(item >> 3, (item & 7) * 8)) = v; }
__device__ __forceinline__ void st_v_item(LAS unsigned char* Vt, int item, u32x4 v) { *(LAS u32x4*)(Vt + (item >> 3) * vstride<64>() + (item & 7) * 16) = v; }
__device__ __forceinline__ void stage_kv_f32_block(const float* __restrict__ src, size_t row_stride, int lane, LAS unsigned char* Kt, LAS unsigned char* Vt, float* __restrict__ copy, size_t copy_stride, int copy_from) {
    f32x4 ka[8], kb[8], va[8], vb[8];
#pragma unroll
    for (int i = 0; i < 8; ++i) { const int item = lane + 64 * i, key = item >> 3, ch = item & 7; const float* s = src + (size_t)key * row_stride + ch * 4; ka[i] = *(const f32x4*)s; kb[i] = *(const f32x4*)(s + 32); }
#pragma unroll
    for (int i = 0; i < 8; ++i) { const int item = lane + 64 * i, key = item >> 3, ch = item & 7; const float* s = src + 256 + (size_t)key * row_stride + ch * 8; va[i] = *(const f32x4*)s; vb[i] = *(const f32x4*)(s + 4); }
#pragma unroll
    for (int i = 0; i < 8; ++i) { const int item = lane + 64 * i, key = item >> 3, ch = item & 7;
        if (copy && key >= copy_from) { float* d = copy + (size_t)key * copy_stride + ch * 4; *(f32x4*)d = ka[i]; *(f32x4*)(d + 32) = kb[i]; }
        u32x4 v; v.x = cvt_pk_bf16(ka[i][0], kb[i][0]); v.y = cvt_pk_bf16(ka[i][1], kb[i][1]); v.z = cvt_pk_bf16(ka[i][2], kb[i][2]); v.w = cvt_pk_bf16(ka[i][3], kb[i][3]); st_k_item(Kt, item, v); }
#pragma unroll
    for (int i = 0; i < 8; ++i) { const int item = lane + 64 * i, key = item >> 3, ch = item & 7;
        if (copy && key >= copy_from) { float* d = copy + 256 + (size_t)key * copy_stride + ch * 8; *(f32x4*)d = va[i]; *(f32x4*)(d + 4) = vb[i]; }
        st_v_item(Vt, item, pack8(va[i], vb[i])); }
}

constexpr float ATT_C = 0.125f * 1.44269504088896f;
constexpr int L_KT = 1024, L_VT = L_KT + 4 * 8192, L_BQ = L_VT + 4 * 10240, L_BE = L_BQ + 32768, L_MISC = L_BE + 32768;

template <int HD> __device__ __forceinline__ void attn_store_bf16(const AttnTile<HD>& T, bf16_t* dst, int lane) {
    const int g = lane >> 4; const float inv = 1.0f / fmaxf(xsum16_32(T.l), 1e-30f);
#pragma unroll
    for (int dt = 0; dt < HD / 16; ++dt) { u32x2 w; w.x = cvt_pk_bf16(T.o[dt][0] * inv, T.o[dt][1] * inv); w.y = cvt_pk_bf16(T.o[dt][2] * inv, T.o[dt][3] * inv); *(u32x2*)(dst + 16 * dt + 4 * g) = w; }
}

__device__ __forceinline__ unsigned fkey(float f) { const unsigned b = __float_as_uint(f); return b ^ ((b >> 31) ? 0xffffffffu : 0x80000000u); }
__device__ __forceinline__ int dpp_xor1(int v) { return __builtin_amdgcn_update_dpp(v, v, 0xB1, 0xF, 0xF, false); }
__device__ __forceinline__ int dpp_xor2(int v) { return __builtin_amdgcn_update_dpp(v, v, 0x4E, 0xF, 0xF, false); }
__device__ __forceinline__ int dpp_hmirror(int v) { return __builtin_amdgcn_update_dpp(v, v, 0x141, 0xF, 0xF, false); }
__device__ __forceinline__ float qsum4(float v) { v += __int_as_float(dpp_xor1(__float_as_int(v))); v += __int_as_float(dpp_xor2(__float_as_int(v))); return v; }
__device__ __forceinline__ int gsum8(int v) { v += dpp_xor1(v); v += dpp_xor2(v); v += dpp_hmirror(v); return v; }

constexpr int C_KT = 1024, C_VT = C_KT + 8 * 8192, C_SC = C_VT + 4 * 10240, C_END = C_SC + 64 * 128 * 4;
static_assert(C_END <= 160 * 1024 - 64, "cmp LDS map");
__device__ __forceinline__ void cmp_unit(const Params& p, bool sample, int unit, LAS unsigned char* lds) {
    constexpr float QSC = 1.0f;
    const int tid = TID(), lane = tid & 63, w = tid >> 6, fr = lane & 15, g = lane >> 4;
    int b, kv, qt, t0, nkeys_tot; size_t row0; const bf16_t *KC, *VC;
    if (!sample) { b = unit >> 9; kv = (unit >> 7) & 3; qt = unit & 127; t0 = qt * 64; row0 = (size_t)b * SEQ + t0; nkeys_tot = NCMP_P;
        KC = p.KCp + (size_t)(b * 4 + kv) * 512 * 64; VC = p.VCp + (size_t)(b * 4 + kv) * 512 * 64; }
    else { b = unit >> 2; kv = unit & 3; qt = PAST / 64; t0 = PAST; row0 = (size_t)MP + b * 8; nkeys_tot = NCMP_S;
        KC = p.KCs + (size_t)(b * 4 + kv) * 128 * 64; VC = p.VCs + (size_t)(b * 4 + kv) * 128 * 64; }
    const bool wact = !sample || w == 0;
    const int tmax = sample ? PAST + 7 : t0 + 63;
    int nv = tmax >= 31 ? (tmax - 31) / 16 + 1 : 0; if (nv > nkeys_tot) nv = nkeys_tot;
    const int nblk = (nv + 63) >> 6;
    AttnTile<64> T[2]; AttnTile<64>* const tp[2] = {&T[0], &T[1]};
    int qpos[2];
#pragma unroll
    for (int u = 0; u < 2; ++u) { T[u].init(); const int tl = 8 * w + 4 * u + (fr >> 2); qpos[u] = t0 + (sample ? (tl & 7) : tl); const size_t row = row0 + (sample ? (tl & 7) : tl);
        const bf16_t* q = p.QN + row * 1024 + (kv * 4 + (fr & 3)) * 64 + 8 * g; T[u].q[0] = ldq_scaled(q, QSC); T[u].q[1] = ldq_scaled(q + 32, QSC); }
    LAS unsigned char* Kt = lds + C_KT; LAS unsigned char* Vt = lds + C_VT;
    LAS float* SC = (LAS float*)(lds + C_SC);
    __syncthreads();
    for (int i = tid; i < 64 * 128; i += 512) SC[i] = 0.f;
    {
        u32x4 rk[8], rv[4];
#pragma unroll
        for (int kb = 0; kb < 8; ++kb) if (kb < nblk) rk[kb] = ld_bf16_item(KC + (size_t)kb * 4096, tid, nv - kb * 64);
#pragma unroll
        for (int kb = 0; kb < 4; ++kb) if (kb < nblk) rv[kb] = ld_bf16_item(VC + (size_t)kb * 4096, tid, nv - kb * 64);
#pragma unroll
        for (int kb = 0; kb < 8; ++kb) if (kb < nblk) st_k_item(Kt + kb * 8192, tid, rk[kb]);
#pragma unroll
        for (int kb = 0; kb < 4; ++kb) if (kb < nblk) st_v_item(Vt + kb * 10240, tid, rv[kb]);
    }
    __syncthreads();
    if (wact) for (int kb = 0; kb < nblk; ++kb) {
        f32x4 s[2][4]; attn_scores<64, 2>(s, tp, Kt + kb * 8192, lane);
#pragma unroll
        for (int u = 0; u < 2; ++u) {
            float mx = NEG_INF;
#pragma unroll
            for (int kt = 0; kt < 4; ++kt)
#pragma unroll
                for (int r = 0; r < 4; ++r) { const int n = kb * 64 + 16 * kt + 4 * g + r; if (16 * n + 31 > qpos[u] || n >= nv) s[u][kt][r] = NEG_INF; mx = fmaxf(mx, s[u][kt][r]); }
            mx = xmax16_32(mx);
            const float mnew = fmaxf(T[u].m, mx), msafe = (mnew == NEG_INF) ? 0.f : mnew, alpha = __builtin_amdgcn_exp2f((T[u].m - msafe) * ATT_C), mc = msafe * ATT_C;
            float ps = 0.f;
#pragma unroll
            for (int kt = 0; kt < 4; ++kt)
#pragma unroll
                for (int r = 0; r < 4; ++r) ps += __builtin_amdgcn_exp2f(s[u][kt][r] * ATT_C - mc);
            T[u].l = T[u].l * alpha + ps; T[u].m = mnew;
        }
    }
    float mfin[2], linv[2];
#pragma unroll
    for (int u = 0; u < 2; ++u) { const float lt = xsum16_32(T[u].l); linv[u] = 1.0f / fmaxf(lt, 1e-30f); mfin[u] = ((T[u].m == NEG_INF) ? 0.f : T[u].m) * ATT_C; }
    for (int kb = 0; kb < nblk; ++kb) {
        if (kb == 4) { __syncthreads();
            { u32x4 rv[4];
#pragma unroll
                for (int k2 = 4; k2 < 8; ++k2) if (k2 < nblk) rv[k2 - 4] = ld_bf16_item(VC + (size_t)k2 * 4096, tid, nv - k2 * 64);
#pragma unroll
                for (int k2 = 4; k2 < 8; ++k2) if (k2 < nblk) st_v_item(Vt + (k2 - 4) * 10240, tid, rv[k2 - 4]); }
            __syncthreads(); }
        if (wact) {
            f32x4 s[2][4]; attn_scores<64, 2>(s, tp, Kt + kb * 8192, lane);
            bf16x8 pf[2][2];
#pragma unroll
            for (int u = 0; u < 2; ++u) {
#pragma unroll
                for (int kt = 0; kt < 4; ++kt) {
                    float qs = 0.f;
#pragma unroll
                    for (int r = 0; r < 4; ++r) { const int n = kb * 64 + 16 * kt + 4 * g + r; const bool ok = (16 * n + 31 <= qpos[u]) && n < nv;
                        const float e = ok ? __builtin_amdgcn_exp2f(s[u][kt][r] * ATT_C - mfin[u]) * linv[u] : 0.f; s[u][kt][r] = e; qs += e; }
                    float es = s[u][kt][3];
                    qs = qsum4(qs); es = qsum4(es);
                    if ((fr & 3) == 0) { const int tl = (sample ? 0 : 8 * w) + 4 * u + (fr >> 2), jq = kb * 16 + 4 * kt + g;
                        __hip_atomic_fetch_add(SC + tl * 128 + jq, qs, __ATOMIC_RELAXED, __HIP_MEMORY_SCOPE_WORKGROUP); if (jq < 127) __hip_atomic_fetch_add(SC + tl * 128 + jq + 1, es, __ATOMIC_RELAXED, __HIP_MEMORY_SCOPE_WORKGROUP); }
                }
#pragma unroll
                for (int ph = 0; ph < 2; ++ph) {
                    u32x4 wv; wv.x = cvt_pk_bf16(s[u][2 * ph][0], s[u][2 * ph][1]); wv.y = cvt_pk_bf16(s[u][2 * ph][2], s[u][2 * ph][3]);
                    wv.z = cvt_pk_bf16(s[u][2 * ph + 1][0], s[u][2 * ph + 1][1]); wv.w = cvt_pk_bf16(s[u][2 * ph + 1][2], s[u][2 * ph + 1][3]);
                    pf[u][ph] = __builtin_bit_cast(bf16x8, wv);
                }
            }
            attn_pv<64, 2>(tp, pf, Vt + (kb & 3) * 10240, lane);
        }
    }
    if (wact) {
#pragma unroll
        for (int u = 0; u < 2; ++u) { const int tl = 8 * w + 4 * u + (fr >> 2); const size_t row = row0 + (sample ? (tl & 7) : tl); bf16_t* dst = p.OCMP + row * 1024 + (kv * 4 + (fr & 3)) * 64;
#pragma unroll
            for (int dt = 0; dt < 4; ++dt) { u32x2 wv; wv.x = cvt_pk_bf16(T[u].o[dt][0], T[u].o[dt][1]); wv.y = cvt_pk_bf16(T[u].o[dt][2], T[u].o[dt][3]); *(u32x2*)(dst + 16 * dt + 4 * g) = wv; } }
        asm volatile("s_waitcnt lgkmcnt(0)" ::: "memory");
        const int tk = lane >> 3, sub = lane & 7, tl = (sample ? 0 : 8 * w) + tk, cur = qt;
        unsigned key[16];
#pragma unroll
        for (int i = 0; i < 16; ++i) { const int j = 16 * sub + i; const float sc = SC[tl * 128 + j];
            const bool forced = (j == 0) || (j == cur) || (j == cur - 1), valid = j <= cur;
            key[i] = fkey(forced ? 1e9f : (valid ? sc : -1.0f)); }
        unsigned thr = 0u;
        for (int bit = 31; bit >= 0; --bit) { const unsigned cand = thr | (1u << bit); int c = 0;
#pragma unroll
            for (int i = 0; i < 16; ++i) c += (key[i] >= cand) ? 1 : 0;
            c = gsum8(c); if (c >= 16) thr = cand; }
        unsigned gtm = 0u, eqm = 0u;
#pragma unroll
        for (int i = 0; i < 16; ++i) { gtm |= (key[i] > thr) ? (1u << i) : 0u; eqm |= (key[i] == thr) ? (1u << i) : 0u; }
        const int ngt = gsum8(__popc(gtm)), neq = __popc(eqm);
        int pre = neq;
        { int v = __shfl_up(pre, 1); if (sub >= 1) pre += v; v = __shfl_up(pre, 2); if (sub >= 2) pre += v; v = __shfl_up(pre, 4); if (sub >= 4) pre += v; }
        int take = (16 - ngt) - (pre - neq); take = take < 0 ? 0 : (take > neq ? neq : take);
        unsigned sel = gtm, em = eqm;
        for (int i = 0; i < take; ++i) { const unsigned low = em & (0u - em); sel |= low; em ^= low; }
        unsigned vm = 0u;
#pragma unroll
        for (int i = 0; i < 16; ++i) vm |= (16 * sub + i <= cur) ? (1u << i) : 0u;
        sel &= vm;
        const unsigned hi = __shfl_down(sel, 1);
        if ((sub & 1) == 0) p.SEL[(row0 + (sample ? tk : 8 * w + tk)) * 16 + kv * 4 + (sub >> 1)] = sel | (hi << 16);
    }
}

__device__ __forceinline__ void slc_merge_store(const Params& p, const AttnTile<64>& T, size_t row, int kv, int lane) {
    const int fr = lane & 15, g = lane >> 4, head = kv * 4 + (fr & 3); const size_t base = row * 1024 + head * 64;
    const float inv = 1.0f / fmaxf(xsum16_32(T.l), 1e-30f);
    const float gc = p.NG[row * 48 + head], gs = p.NG[row * 48 + 16 + head], gw = p.NG[row * 48 + 32 + head];
    u32x2 ga[4], gb[4], hg[4], oc[4], ow[4];
#pragma unroll
    for (int dt = 0; dt < 4; ++dt) { const size_t o = base + 16 * dt + 4 * g; ga[dt] = *(const u32x2*)(p.GA + o); gb[dt] = *(const u32x2*)(p.GB + o); hg[dt] = *(const u32x2*)(p.OHG + o); oc[dt] = *(const u32x2*)(p.OCMP + o); ow[dt] = *(const u32x2*)(p.OWIN + o); }
#pragma unroll
    for (int dt = 0; dt < 4; ++dt) { const size_t o = base + 16 * dt + 4 * g;
        float r[4];
        r[0] = lo_bf(ga[dt].x) * lo_bf(hg[dt].x) + lo_bf(gb[dt].x) * (gc * lo_bf(oc[dt].x) + gs * T.o[dt][0] * inv + gw * lo_bf(ow[dt].x));
        r[1] = hi_bf(ga[dt].x) * hi_bf(hg[dt].x) + hi_bf(gb[dt].x) * (gc * hi_bf(oc[dt].x) + gs * T.o[dt][1] * inv + gw * hi_bf(ow[dt].x));
        r[2] = lo_bf(ga[dt].y) * lo_bf(hg[dt].y) + lo_bf(gb[dt].y) * (gc * lo_bf(oc[dt].y) + gs * T.o[dt][2] * inv + gw * lo_bf(ow[dt].y));
        r[3] = hi_bf(ga[dt].y) * hi_bf(hg[dt].y) + hi_bf(gb[dt].y) * (gc * hi_bf(oc[dt].y) + gs * T.o[dt][3] * inv + gw * hi_bf(ow[dt].y));
        u32x2 wv; wv.x = cvt_pk_bf16(r[0], r[1]); wv.y = cvt_pk_bf16(r[2], r[3]); *(u32x2*)(p.MERGED + o) = wv; }
}
constexpr int S_BUF = 4 * (8192 + 10240);
constexpr int W_TILE = 8192 + 10240;
__device__ __forceinline__ void wave_partials_put(LAS float* PX, const AttnTile<64> (&T)[2], int w, int lane) {
#pragma unroll
    for (int u = 0; u < 2; ++u) { LAS float* d = PX + (size_t)((w * 2 + u) * 18) * 64 + lane;
#pragma unroll
        for (int k = 0; k < 16; ++k) d[k * 64] = T[u].o[k >> 2][k & 3];
        d[16 * 64] = T[u].m; d[17 * 64] = T[u].l; }
}
__device__ __forceinline__ void wave_partials_merge(const LAS float* PX, AttnTile<64>& R, int u, int lane, float c) {
    float M = NEG_INF;
#pragma unroll
    for (int ww = 0; ww < 8; ++ww) M = fmaxf(M, PX[(size_t)((ww * 2 + u) * 18 + 16) * 64 + lane]);
    const float Ms = (M == NEG_INF) ? 0.f : M;
    R.init(); R.m = M;
#pragma unroll
    for (int ww = 0; ww < 8; ++ww) { const LAS float* s = PX + (size_t)((ww * 2 + u) * 18) * 64 + lane; const float f = __builtin_amdgcn_exp2f(s[16 * 64] - Ms);
        R.l += s[17 * 64] * f;
#pragma unroll
        for (int k = 0; k < 16; ++k) R.o[k >> 2][k & 3] += s[k * 64] * f; }
}
__device__ __forceinline__ void slc_unit_sample(const Params& p, int unit, LAS unsigned char* lds) {
    constexpr float QSC = ATT_C;
    const int lane = TID() & 63, w = TID() >> 6, fr = lane & 15, g = lane >> 4;
    const int b = unit >> 2, kv = unit & 3; const size_t row0 = (size_t)MP + b * 8;
    AttnTile<64> T[2]; unsigned sel0[2], sel1[2]; int tok[2];
#pragma unroll
    for (int u = 0; u < 2; ++u) { T[u].init(); tok[u] = 4 * u + (fr >> 2); const size_t row = row0 + tok[u];
        const bf16_t* q = p.QR + row * 1024 + (kv * 4 + (fr & 3)) * 64 + 8 * g; T[u].q[0] = ldq_scaled(q, QSC); T[u].q[1] = ldq_scaled(q + 32, QSC);
        sel0[u] = p.SEL[row * 16 + kv * 4]; sel1[u] = p.SEL[row * 16 + kv * 4 + 1]; }
    LAS unsigned char* Kt = lds + 1024 + w * W_TILE; LAS unsigned char* Vt = Kt + 8192;
    const int pg0 = p.page_table[b * NPAGES + (w >> 1)], pg1 = p.page_table[b * NPAGES + ((w + 8) >> 1)], pg2 = p.page_table[b * NPAGES + ((w + 16) >> 1)], pg3 = p.page_table[b * NPAGES + ((w + 24) >> 1)];
    __syncthreads();
    for (int j = w; j <= PAST / 64; j += 8) {
        bool mybit[2], act[2];
#pragma unroll
        for (int u = 0; u < 2; ++u) { mybit[u] = ((j < 32 ? sel0[u] >> j : sel1[u]) & 1u) != 0u; act[u] = __ballot(mybit[u]) != 0ull; }
        if (!act[0] && !act[1]) continue;
        if (j < PAST / 64) {
            const int ji = j >> 3, page = ji == 0 ? pg0 : ji == 1 ? pg1 : ji == 2 ? pg2 : pg3; const float* src = p.cache_slc + ((size_t)page * PAGE + (j & 1) * 64) * 512 + kv * 64;
            stage_kv_f32_block(src, 512, lane, Kt, Vt, nullptr, 0, 0);
        } else {
#pragma unroll
            for (int i = 0; i < 8; ++i) { st_k_item(Kt, lane + 64 * i, ld_bf16_item(p.SKs + ((size_t)kv * MS + b * 8) * 64, lane + 64 * i, 8)); st_v_item(Vt, lane + 64 * i, ld_bf16_item(p.SVs + ((size_t)kv * MS + b * 8) * 64, lane + 64 * i, 8)); }
        }
        const int kbase = j * 64;
        attn_block_sel(T, act[0], act[1], Kt, Vt, ATT_C, [&](int u) { return mybit[u]; }, j == PAST / 64, [&](int u, int kl) { return kbase + kl <= PAST + tok[u]; }, lane);
    }
    __syncthreads();
    LAS float* PX = (LAS float*)(lds + 1024);
    wave_partials_put(PX, T, w, lane);
    __syncthreads();
    if (w < 2) { AttnTile<64> R; wave_partials_merge(PX, R, w, lane, ATT_C); slc_merge_store(p, R, row0 + 4 * w + (fr >> 2), kv, lane); }
}

__device__ __forceinline__ void win_unit_sample(const Params& p, int unit, LAS unsigned char* lds) {
    constexpr float QSC = ATT_C;
    const int lane = TID() & 63, w = TID() >> 6, fr = lane & 15, g = lane >> 4;
    const int b = unit >> 2, kv = unit & 3; const size_t row0 = (size_t)MP + b * 8;
    AttnTile<64> T[2];
#pragma unroll
    for (int u = 0; u < 2; ++u) { T[u].init(); const size_t row = row0 + 4 * u + (fr >> 2);
        const bf16_t* q = p.QR + row * 1024 + (kv * 4 + (fr & 3)) * 64 + 8 * g; T[u].q[0] = ldq_scaled(q, QSC); T[u].q[1] = ldq_scaled(q + 32, QSC); }
    LAS unsigned char* Kt = lds + 1024 + w * W_TILE; LAS unsigned char* Vt = Kt + 8192;
    __syncthreads();
    for (int kb = w; kb < 9; kb += 8) {
        if (kb < 8) {
            const float* src = p.cache_win + ((size_t)b * WIN + kb * 64) * 512 + kv * 64;
            float* cp = p.out + OFF_SWIN + ((size_t)b * WIN + kb * 64 - DSEQ) * 512 + kv * 64;
            const int cf = kb == 0 ? DSEQ : 0;
            stage_kv_f32_block(src, 512, lane, Kt, Vt, cp, 512, cf);
        } else {
#pragma unroll
            for (int i = 0; i < 8; ++i) { st_k_item(Kt, lane + 64 * i, ld_bf16_item(p.WKs + ((size_t)kv * MS + b * 8) * 64, lane + 64 * i, 8)); st_v_item(Vt, lane + 64 * i, ld_bf16_item(p.WVs + ((size_t)kv * MS + b * 8) * 64, lane + 64 * i, 8)); }
        }
        attn_block2<64>(T, Kt, Vt, ATT_C, kb == 0 || kb == 8, [&](int u, int kl) { const int tok = 4 * u + (fr >> 2); return kb == 0 ? (kl > tok) : (kl <= tok); }, lane);
    }
    __syncthreads();
    LAS float* PX = (LAS float*)(lds + 1024);
    wave_partials_put(PX, T, w, lane);
    __syncthreads();
    if (w < 2) { AttnTile<64> R; wave_partials_merge(PX, R, w, lane, ATT_C); const size_t row = row0 + 4 * w + (fr >> 2); attn_store_bf16<64>(R, p.OWIN + row * 1024 + (kv * 4 + (fr & 3)) * 64, lane); }
}

__device__ __forceinline__ void win_unit_prompt(const Params& p, int unit, LAS unsigned char* lds) {
    constexpr float QSC = ATT_C;
    const int tid = TID(), lane = tid & 63, w = tid >> 6, fr = lane & 15, g = lane >> 4;
    const int b = unit >> 9, kv = (unit >> 7) & 3, qt = unit & 127, t0 = qt * 64;
    AttnTile<64> T[2];
#pragma unroll
    for (int u = 0; u < 2; ++u) { T[u].init(); const size_t row = (size_t)b * SEQ + t0 + 8 * w + 4 * u + (fr >> 2);
        const bf16_t* q = p.QR + row * 1024 + (kv * 4 + (fr & 3)) * 64 + 8 * g; T[u].q[0] = ldq_scaled(q, QSC); T[u].q[1] = ldq_scaled(q + 32, QSC); }
    const int kb0 = qt >= 8 ? qt - 8 : 0, nb = qt - kb0 + 1, nround = (nb + 1) >> 1;
    const bf16_t* Kg = p.WKp + ((size_t)kv * MP + (size_t)b * SEQ + (size_t)kb0 * 64) * 64; const bf16_t* Vg = p.WVp + ((size_t)kv * MP + (size_t)b * SEQ + (size_t)kb0 * 64) * 64;
    u32x4 rk[2], rv[2];
#pragma unroll
    for (int jj = 0; jj < 2; ++jj) if (jj < nb) { rk[jj] = ld_bf16_item(Kg + (size_t)jj * 4096, tid, 64); rv[jj] = ld_bf16_item(Vg + (size_t)jj * 4096, tid, 64); }
    __syncthreads();
#pragma unroll
    for (int jj = 0; jj < 2; ++jj) if (jj < nb) { st_k_item(lds + 1024 + jj * 8192, tid, rk[jj]); st_v_item(lds + 1024 + 32768 + jj * 10240, tid, rv[jj]); }
    __syncthreads();
    for (int r = 0; r < nround; ++r) {
        const LAS unsigned char* buf = lds + 1024 + (r & 1) * S_BUF;
        const bool more = r + 1 < nround;
        if (more) {
#pragma unroll
            for (int jj = 0; jj < 2; ++jj) { const int j = 2 * (r + 1) + jj; if (j < nb) { rk[jj] = ld_bf16_item(Kg + (size_t)j * 4096, tid, 64); rv[jj] = ld_bf16_item(Vg + (size_t)j * 4096, tid, 64); } }
        }
#pragma unroll
        for (int jj = 0; jj < 2; ++jj) { const int j = 2 * r + jj; if (j >= nb) break;
            const int kb = kb0 + j, kbase = kb * 64;
            attn_block2<64>(T, buf + jj * 8192, buf + 32768 + jj * 10240, ATT_C, kb == qt || kb == qt - 8, [&](int u, int kl) { const int qpos = t0 + 8 * w + 4 * u + (fr >> 2), kpos = kbase + kl; return kpos <= qpos && kpos > qpos - WIN; }, lane);
        }
        if (more) {
            LAS unsigned char* nbuf = lds + 1024 + ((r + 1) & 1) * S_BUF;
#pragma unroll
            for (int jj = 0; jj < 2; ++jj) { const int j = 2 * (r + 1) + jj; if (j < nb) { st_k_item(nbuf + jj * 8192, tid, rk[jj]); st_v_item(nbuf + 32768 + jj * 10240, tid, rv[jj]); } }
        }
        __syncthreads();
    }
#pragma unroll
    for (int u = 0; u < 2; ++u) { const int qpos = t0 + 8 * w + 4 * u + (fr >> 2);
        if (qpos < WIN - 1) { const float mnew = fmaxf(T[u].m, 0.f), alpha = __builtin_amdgcn_exp2f(T[u].m - mnew);
            T[u].l = T[u].l * alpha + (g == 0 ? (float)(WIN - 1 - qpos) * __builtin_amdgcn_exp2f(-mnew) : 0.f); T[u].m = mnew;
#pragma unroll
            for (int dt = 0; dt < 4; ++dt) T[u].o[dt] *= alpha; } }
#pragma unroll
    for (int u = 0; u < 2; ++u) { const size_t row = (size_t)b * SEQ + t0 + 8 * w + 4 * u + (fr >> 2); attn_store_bf16<64>(T[u], p.OWIN + row * 1024 + (kv * 4 + (fr & 3)) * 64, lane); }
}

constexpr int R_FLAGS = 1024 + 8 * W_TILE;
__device__ __forceinline__ unsigned lds_ld_u32(const volatile LAS unsigned* p) { return *p; }
__device__ __forceinline__ void slc_unit_prompt_ring(const Params& p, int unit, LAS unsigned char* lds) {
    constexpr float QSC = ATT_C;
    const int tid = TID(), lane = tid & 63, w = __builtin_amdgcn_readfirstlane(tid >> 6), fr = lane & 15, g = lane >> 4;
    const int b = unit >> 9, kv = (unit >> 7) & 3, cur = unit & 127, t0 = cur * 64; const size_t row0 = (size_t)b * SEQ + t0;
    AttnTile<64> T[2]; unsigned selw[2][4]; int qpos[2]; size_t rowu[2];
#pragma unroll
    for (int u = 0; u < 2; ++u) { T[u].init(); const int tl = 8 * w + 4 * u + (fr >> 2); qpos[u] = t0 + tl; rowu[u] = row0 + tl;
        const bf16_t* q = p.QR + rowu[u] * 1024 + (kv * 4 + (fr & 3)) * 64 + 8 * g; T[u].q[0] = ldq_scaled(q, QSC); T[u].q[1] = ldq_scaled(q + 32, QSC);
        const u32x4 sw = *(const u32x4*)(p.SEL + rowu[u] * 16 + kv * 4); selw[u][0] = sw.x; selw[u][1] = sw.y; selw[u][2] = sw.z; selw[u][3] = sw.w; }
    const bf16_t* Kg = p.SKp + ((size_t)kv * MP + (size_t)b * SEQ) * 64; const bf16_t* Vg = p.SVp + ((size_t)kv * MP + (size_t)b * SEQ) * 64;
    volatile LAS unsigned* ready = (volatile LAS unsigned*)(lds + R_FLAGS); volatile LAS unsigned* done = ready + 8;
    u32x4 rk[8], rv[8];
    auto issue = [&](int pb) {
#pragma unroll
        for (int i = 0; i < 8; ++i) { rk[i] = *(const u32x4*)(Kg + (size_t)pb * 4096 + (size_t)(lane + 64 * i) * 8); rv[i] = *(const u32x4*)(Vg + (size_t)pb * 4096 + (size_t)(lane + 64 * i) * 8); }
    };
    auto commit = [&](int pb) {
        const int slot = pb & 7; const unsigned want = 8u * (unsigned)(pb >> 3);
        unsigned spins = 0; while (lds_ld_u32(done + slot) < want && ++spins < (1u << 22)) __builtin_amdgcn_s_sleep(1);
        LAS unsigned char* Kt = lds + 1024 + slot * W_TILE; LAS unsigned char* Vt = Kt + 8192;
#pragma unroll
        for (int i = 0; i < 8; ++i) { st_k_item(Kt, lane + 64 * i, rk[i]); st_v_item(Vt, lane + 64 * i, rv[i]); }
        asm volatile("s_waitcnt lgkmcnt(0)" ::: "memory");
        if (lane == 0) ready[slot] = (unsigned)(pb >> 3) + 1u;
    };
    __syncthreads();
    if (tid < 16) ready[tid] = 0u;
    __syncthreads();
    if (w <= cur) { issue(w); commit(w); }
    for (int j = 0; j <= cur; ++j) {
        const int pc = j + 3;
        if (pc >= 8 && pc <= cur && (pc & 7) == w) { issue(pc); commit(pc); }
        const int slot = j & 7;
        bool mybit[2], act[2];
#pragma unroll
        for (int u = 0; u < 2; ++u) { const unsigned wd = (j >> 5) == 0 ? selw[u][0] : (j >> 5) == 1 ? selw[u][1] : (j >> 5) == 2 ? selw[u][2] : selw[u][3]; mybit[u] = (wd >> (j & 31)) & 1u; act[u] = __ballot(mybit[u]) != 0ull; }
        if (act[0] || act[1]) {
            const unsigned want = (unsigned)(j >> 3) + 1u;
            unsigned spins = 0; while (lds_ld_u32(ready + slot) < want && ++spins < (1u << 22)) __builtin_amdgcn_s_sleep(1);
            const LAS unsigned char* Kt = lds + 1024 + slot * W_TILE;
            const int kbase = j * 64;
            attn_block_sel(T, act[0], act[1], Kt, Kt + 8192, ATT_C, [&](int u) { return mybit[u]; }, j == cur, [&](int u, int kl) { return kbase + kl <= qpos[u]; }, lane);
            asm volatile("s_waitcnt lgkmcnt(0)" ::: "memory");
        }
        if (lane == 0) __hip_atomic_fetch_add((LAS unsigned*)(done + slot), 1u, __ATOMIC_RELAXED, __HIP_MEMORY_SCOPE_WORKGROUP);
    }
#pragma unroll
    for (int u = 0; u < 2; ++u) slc_merge_store(p, T[u], rowu[u], kv, lane);
}
struct EpiCmp {
    static constexpr bool PERM = true, AFTER_DRAIN = false;
    bf16_t* C;
    __device__ __forceinline__ void operator()(const f32x4 (&acc)[2][2][4][2], const pg8::Unit& u, int wr, int wc, int fr, int fq) const {
        EPI_FOR_FRAGS({ *(u32x4*)(C + (size_t)row * 256 + cl) = pack8(v0, v1); })
    }
    __device__ __forceinline__ void small(int row, int col, const f32x4 a0, const f32x4 a1, int) const { *(u32x4*)(C + (size_t)row * 256 + col) = pack8(a0, a1); }
};
__device__ __forceinline__ float gelu_tanh(float x) { const float y = 0.7978845608028654f * (x + 0.044715f * x * x * x); const float e = fast_exp(2.0f * y); return x * (1.0f - __builtin_amdgcn_rcpf(1.0f + e)); }
__device__ __forceinline__ void cmp_stage2(const Params& p) {
    const int lane = TID() & 63, fr = lane & 15, g = lane >> 4;
    const int gw = blockIdx.x * 8 + (TID() >> 6), nw = gridDim.x * 8;
    constexpr int NT_P = 2 * 8 * 32, NT_S = 2 * 512 * 8;
    for (int tile = gw; tile < NT_P + NT_S; tile += nw) {
        int sel, grp, i0, ntok; size_t arow0; bf16_t* dst;
        if (tile < NT_P) { sel = tile >> 8; grp = (tile >> 5) & 7; i0 = (tile & 31) * 16; ntok = NCMP_P; const int kv = grp >> 1, b = grp & 1;
            arow0 = (size_t)sel * 69632 + grp * 512; dst = (sel ? p.VCp : p.KCp) + (size_t)(b * 4 + kv) * 512 * 64; }
        else { const int t2 = tile - NT_P; sel = t2 >> 12; grp = (t2 >> 3) & 511; i0 = (t2 & 7) * 16; ntok = NCMP_S; const int kv = grp >> 7, b = grp & 127;
            arow0 = (size_t)sel * 69632 + 4096 + (size_t)grp * 128; dst = (sel ? p.VCs : p.KCs) + (size_t)(b * 4 + kv) * 128 * 64; }
        const int i = i0 + fr; const bool ok = i < ntok; const int ic = ok ? i : ntok - 1;
        const bf16_t* c1 = (const bf16_t*)p.CCp + (arow0 + ic) * 256; const bf16_t* c2 = (const bf16_t*)p.CCp + (arow0 + ic + 1) * 256 + 128;
        f32x4 acc[4];
#pragma unroll
        for (int nt = 0; nt < 4; ++nt) acc[nt] = (f32x4){0.f, 0.f, 0.f, 0.f};
#pragma unroll
        for (int ks = 0; ks < 4; ++ks) {
            const int h = 32 * ks + 8 * g; float hv[8];
            { const u32x4 a = *(const u32x4*)(c1 + h), b2 = *(const u32x4*)(c2 + h); const f32x4 pb0 = *(const f32x4*)(p.posb + sel * 128 + h), pb1 = *(const f32x4*)(p.posb + sel * 128 + h + 4);
                hv[0] = gelu_tanh(lo_bf(a.x) + lo_bf(b2.x) + pb0[0]); hv[1] = gelu_tanh(hi_bf(a.x) + hi_bf(b2.x) + pb0[1]); hv[2] = gelu_tanh(lo_bf(a.y) + lo_bf(b2.y) + pb0[2]); hv[3] = gelu_tanh(hi_bf(a.y) + hi_bf(b2.y) + pb0[3]);
                hv[4] = gelu_tanh(lo_bf(a.z) + lo_bf(b2.z) + pb1[0]); hv[5] = gelu_tanh(hi_bf(a.z) + hi_bf(b2.z) + pb1[1]); hv[6] = gelu_tanh(lo_bf(a.w) + lo_bf(b2.w) + pb1[2]); hv[7] = gelu_tanh(hi_bf(a.w) + hi_bf(b2.w) + pb1[3]); }
            u32x4 w; w.x = cvt_pk_bf16(hv[0], hv[1]); w.y = cvt_pk_bf16(hv[2], hv[3]); w.z = cvt_pk_bf16(hv[4], hv[5]); w.w = cvt_pk_bf16(hv[6], hv[7]);
            const bf16x8 af = __builtin_bit_cast(bf16x8, w);
#pragma unroll
            for (int nt = 0; nt < 4; ++nt) { const bf16x8 bfr = *(const bf16x8*)(p.W2t + (size_t)sel * 64 * 128 + (size_t)(16 * nt + fr) * 128 + h); acc[nt] = __builtin_amdgcn_mfma_f32_16x16x32_bf16(bfr, af, acc[nt], 0, 0, 0); }
        }
        if (ok) {
#pragma unroll
            for (int nt = 0; nt < 4; ++nt) { u32x2 wv; wv.x = cvt_pk_bf16(acc[nt][0], acc[nt][1]); wv.y = cvt_pk_bf16(acc[nt][2], acc[nt][3]); *(u32x2*)(dst + (size_t)i * 64 + 16 * nt + 4 * g) = wv; }
        }
    }
}


constexpr int CG_BT = 1024, CG_BTB = 256 * 64 * 2;
__device__ __forceinline__ void cmp_gemm_sample_unit(const Params& p, int upair, LAS unsigned char* lds) {
    const int tid = TID(), lane = tid & 63, w = tid >> 6, fr = lane & 15, g = lane >> 4;
    const int sel = upair >> 8, kv = (upair >> 6) & 3, b0 = (upair & 63) * 2;
    const bf16_t* Bg = p.W1t + (size_t)sel * 256 * 1024;
    const float* arow[2];
#pragma unroll
    for (int ub = 0; ub < 2; ++ub) { const int n = 16 * w + fr; const int page = p.page_table[(b0 + ub) * NPAGES + (n >> 3)];
        arow[ub] = p.cache_cmp + ((size_t)page * PAGE + (n & 7) * 16) * 512 + sel * 256 + kv * 64 + 8 * g; }
    f32x4 acc[2][16];
#pragma unroll
    for (int ub = 0; ub < 2; ++ub)
#pragma unroll
        for (int nt = 0; nt < 16; ++nt) acc[ub][nt] = (f32x4){0.f, 0.f, 0.f, 0.f};
    f32x4 ra[2][2][2];
    u32x4 rb[4];
    auto lda = [&](int s) {
#pragma unroll
        for (int ub = 0; ub < 2; ++ub)
#pragma unroll
            for (int ks = 0; ks < 2; ++ks) { const float* q = arow[ub] + (size_t)s * 512 + 32 * ks; ra[ub][ks][0] = *(const f32x4*)q; ra[ub][ks][1] = *(const f32x4*)(q + 4); } };
    auto ldb = [&](int s) {
#pragma unroll
        for (int i = 0; i < 4; ++i) { const int c = tid + 512 * i, col = c >> 3, ch = c & 7; rb[i] = *(const u32x4*)(Bg + (size_t)col * 1024 + s * 64 + ch * 8); } };
    auto stb = [&](LAS unsigned char* Bt) {
#pragma unroll
        for (int i = 0; i < 4; ++i) { const int c = tid + 512 * i, col = c >> 3, ch = c & 7; *(LAS u32x4*)(Bt + ktile_byte<64>(col, ch * 8)) = rb[i]; } };
    lda(0); ldb(0);
    __syncthreads();
    stb(lds + CG_BT);
    __syncthreads();
    for (int s = 0; s < 16; ++s) {
        bf16x8 af[2][2];
#pragma unroll
        for (int ub = 0; ub < 2; ++ub)
#pragma unroll
            for (int ks = 0; ks < 2; ++ks) af[ub][ks] = __builtin_bit_cast(bf16x8, pack8(ra[ub][ks][0], ra[ub][ks][1]));
        if (s < 15) { lda(s + 1); ldb(s + 1); }
        const LAS unsigned char* Bt = lds + CG_BT + (s & 1) * CG_BTB;
#pragma unroll
        for (int ks = 0; ks < 2; ++ks)
#pragma unroll
            for (int nt = 0; nt < 16; ++nt) { const bf16x8 bfr = *(const LAS bf16x8*)(Bt + ktile_byte<64>(16 * nt + fr, 32 * ks + 8 * g));
#pragma unroll
                for (int ub = 0; ub < 2; ++ub) acc[ub][nt] = __builtin_amdgcn_mfma_f32_16x16x32_bf16(bfr, af[ub][ks], acc[ub][nt], 0, 0, 0); }
        if (s < 15) stb(lds + CG_BT + ((s + 1) & 1) * CG_BTB);
        __syncthreads();
    }
#pragma unroll
    for (int ub = 0; ub < 2; ++ub) {
        bf16_t* C = (bf16_t*)p.CCp + ((size_t)sel * 69632 + 4096 + (size_t)(kv * 128 + b0 + ub) * 128 + 16 * w + fr) * 256;
#pragma unroll
        for (int nt = 0; nt < 16; ++nt) { u32x2 wv; wv.x = cvt_pk_bf16(acc[ub][nt][0], acc[ub][nt][1]); wv.y = cvt_pk_bf16(acc[ub][nt][2], acc[ub][nt][3]); *(u32x2*)(C + 16 * nt + 4 * g) = wv; }
    }
}

template <int HDV> __device__ __forceinline__ int vt_byte(int row, int col) { return row * (HDV * 2 + 32) + col * 2; }
constexpr int H_GL = 1024, H_QT = H_GL + 64 * 132 * 4, H_KT = H_QT + 16384, H_KE = H_KT + 16384, H_V = H_KE + 64 * 288, H_ST = H_V + 64 * 288, H_VEC = H_ST + 32768, H_END = H_VEC + 24 * 128 * 4;
static_assert(H_END <= 160 * 1024 - 64, "HGRN LDS map too large");

template <bool OUT> __device__ __forceinline__ void hgrn_task(const Params& p, int task, LAS unsigned char* lds) {
    const int tid = TID(), lane = tid & 63, w = tid >> 6, fr = lane & 15, g = lane >> 4;
    const int b = task >> 8, h = (task >> 5) & 7, sc = task & 31;
    const size_t row0 = (size_t)b * SEQ + sc * 256;
    LAS float* GL = (LAS float*)(lds + H_GL);
    LAS unsigned char* QT = lds + H_QT;
    LAS unsigned char* KT = lds + H_KT;
    LAS unsigned char* KE = lds + H_KE;
    LAS unsigned char* VV = lds + H_V;
    LAS unsigned char* ST = lds + H_ST;
    LAS float* VEC = (LAS float*)(lds + H_VEC);
    f32x4 sacc[8];
#pragma unroll
    for (int vt = 0; vt < 8; ++vt) sacc[vt] = (f32x4){0.f, 0.f, 0.f, 0.f};
    __syncthreads();
    if (OUT) {
        const float* S0 = p.Lloc + (size_t)task * 16384;
#pragma unroll
        for (int vt = 0; vt < 8; ++vt)
#pragma unroll
            for (int r = 0; r < 4; ++r) sacc[vt][r] = S0[(size_t)(16 * w + 4 * g + r) * 128 + 16 * vt + fr];
    } else if (tid < 128) VEC[9 * 128 + tid] = 0.f;
    for (int step = 0; step < 4; ++step) {
        const size_t r0 = row0 + step * 64;
        const int k = tid & 127, sub = tid >> 7;
        float gl[16], gr[16], gsum = 0.f;
#pragma unroll
        for (int i = 0; i < 16; ++i) gr[i] = p.G[(r0 + sub * 16 + i) * 1024 + h * 128 + k];
#pragma unroll
        for (int i = 0; i < 16; ++i) { gsum += gr[i]; gl[i] = gsum; }
        VEC[sub * 128 + k] = gsum;
        if (OUT) {
#pragma unroll
            for (int vt = 0; vt < 8; ++vt) { u32x2 wv; wv.x = cvt_pk_bf16(sacc[vt][0], sacc[vt][1]); wv.y = cvt_pk_bf16(sacc[vt][2], sacc[vt][3]); *(LAS u32x2*)(ST + ktile_byte<128>(16 * vt + fr, 16 * w + 4 * g)) = wv; }
        }
        {
            const int s = tid >> 3, ch = tid & 7;
            const u32x4 a = *(const u32x4*)(p.HV + (r0 + s) * 1024 + h * 128 + ch * 16), b2 = *(const u32x4*)(p.HV + (r0 + s) * 1024 + h * 128 + ch * 16 + 8);
            *(LAS u32x4*)(VV + vt_byte<128>(s, ch * 16)) = a; *(LAS u32x4*)(VV + vt_byte<128>(s, ch * 16 + 8)) = b2;
        }
        __syncthreads();
        {
            float bi = 0.f, gend = 0.f;
#pragma unroll
            for (int i = 0; i < 4; ++i) { const float tv = VEC[i * 128 + k]; if (i < sub) bi += tv; gend += tv; }
            const float gmid = gl[7];
            if (sub == 0) { VEC[8 * 128 + k] = gend; }
            VEC[(4 + sub) * 128 + k] = bi + gmid;
            const float etail = gend - bi;
#pragma unroll
            for (int i = 0; i < 16; ++i) {
                const int t = sub * 16 + i;
                const float kk = 1.0f - fast_exp(gr[i]);
                if (OUT) { const float qv = bf2f(p.HQ[(r0 + t) * 1024 + h * 128 + k]);
                    *(LAS bf16_t*)(QT + ktile_byte<128>(t, k)) = f2bf(qv * fast_exp(gl[i] - gmid));
                    *(LAS bf16_t*)(KT + ktile_byte<128>(t, k)) = f2bf(kk * fast_exp(gmid - gl[i])); }
                *(LAS bf16_t*)(KE + vt_byte<128>(t, k)) = f2bf(kk * fast_exp(etail - gl[i]));
            }
        }
        __syncthreads();
        if (OUT) {
            for (int e = tid; e < 10 * 128; e += 512) { const int rowi = e >> 7, kx = e & 127;
                float v;
                if (rowi < 4) v = fast_exp(VEC[(4 + rowi) * 128 + kx]);
                else { const int pr = rowi - 4, pi = pr == 0 ? 1 : pr < 3 ? 2 : 3, pj = pr == 0 ? 0 : pr == 1 ? 0 : pr == 2 ? 1 : pr - 3; v = fast_exp(VEC[(4 + pi) * 128 + kx] - VEC[(4 + pj) * 128 + kx]); }
                VEC[(12 + rowi) * 128 + kx] = v; }
            __syncthreads();
            const int ti = w & 3, vh = w >> 2;
            bf16x8 qf[4];
#pragma unroll
            for (int ks = 0; ks < 4; ++ks) qf[ks] = *(const LAS bf16x8*)(QT + ktile_byte<128>(16 * ti + fr, 32 * ks + 8 * g));
            f32x4 at[4];
#pragma unroll
            for (int sj = 0; sj < 4; ++sj) { at[sj] = (f32x4){0.f, 0.f, 0.f, 0.f};
                if (sj <= ti) {
#pragma unroll
                    for (int ks = 0; ks < 4; ++ks) {
                        bf16x8 qs = qf[ks];
                        if (sj < ti) { float f[8]; const int prow = 16 + (ti == 1 ? 0 : ti == 2 ? 1 + sj : 3 + sj);
                            const f32x4 d0 = *(const LAS f32x4*)(VEC + prow * 128 + 32 * ks + 8 * g), d1 = *(const LAS f32x4*)(VEC + prow * 128 + 32 * ks + 8 * g + 4);
#pragma unroll
                            for (int j = 0; j < 8; ++j) f[j] = bf2f((bf16_t)qf[ks][j]) * (j < 4 ? d0[j & 3] : d1[j & 3]);
                            u32x4 wv; wv.x = cvt_pk_bf16(f[0], f[1]); wv.y = cvt_pk_bf16(f[2], f[3]); wv.z = cvt_pk_bf16(f[4], f[5]); wv.w = cvt_pk_bf16(f[6], f[7]); qs = __builtin_bit_cast(bf16x8, wv); }
                        const bf16x8 kf = *(const LAS bf16x8*)(KT + ktile_byte<128>(16 * sj + fr, 32 * ks + 8 * g));
                        at[sj] = __builtin_amdgcn_mfma_f32_16x16x32_bf16(kf, qs, at[sj], 0, 0, 0);
                    }
                    if (sj == ti) {
#pragma unroll
                        for (int r = 0; r < 4; ++r) if (4 * g + r > fr) at[sj][r] = 0.f;
                    }
                } }
            bf16x8 pf[2];
#pragma unroll
            for (int ph = 0; ph < 2; ++ph) { u32x4 wv; wv.x = cvt_pk_bf16(at[2 * ph][0], at[2 * ph][1]); wv.y = cvt_pk_bf16(at[2 * ph][2], at[2 * ph][3]);
                wv.z = cvt_pk_bf16(at[2 * ph + 1][0], at[2 * ph + 1][1]); wv.w = cvt_pk_bf16(at[2 * ph + 1][2], at[2 * ph + 1][3]); pf[ph] = __builtin_bit_cast(bf16x8, wv); }
            bf16x8 qin[4];
#pragma unroll
            for (int ks = 0; ks < 4; ++ks) { float f[8]; const f32x4 d0 = *(const LAS f32x4*)(VEC + (12 + ti) * 128 + 32 * ks + 8 * g), d1 = *(const LAS f32x4*)(VEC + (12 + ti) * 128 + 32 * ks + 8 * g + 4);
#pragma unroll
                for (int j = 0; j < 8; ++j) f[j] = bf2f((bf16_t)qf[ks][j]) * (j < 4 ? d0[j & 3] : d1[j & 3]);
                u32x4 wv; wv.x = cvt_pk_bf16(f[0], f[1]); wv.y = cvt_pk_bf16(f[2], f[3]); wv.z = cvt_pk_bf16(f[4], f[5]); wv.w = cvt_pk_bf16(f[6], f[7]); qin[ks] = __builtin_bit_cast(bf16x8, wv); }
            f32x4 ot[4]; float ss = 0.f;
#pragma unroll
            for (int vi = 0; vi < 4; ++vi) { const int vt = 4 * vh + vi; ot[vi] = (f32x4){0.f, 0.f, 0.f, 0.f};
#pragma unroll
                for (int ks = 0; ks < 4; ++ks) { const bf16x8 sf = *(const LAS bf16x8*)(ST + ktile_byte<128>(16 * vt + fr, 32 * ks + 8 * g)); ot[vi] = __builtin_amdgcn_mfma_f32_16x16x32_bf16(sf, qin[ks], ot[vi], 0, 0, 0); }
#pragma unroll
                for (int ph = 0; ph < 2; ++ph) { if (2 * ph > ti) continue;
                    const LAS unsigned char* vb = VV + vt_byte<128>(32 * ph + 4 * g + (fr >> 2), 16 * vt + 4 * (fr & 3));
                    const s16x4 a = __builtin_amdgcn_ds_read_tr16_b64_v4i16((LAS s16x4*)vb), b2 = __builtin_amdgcn_ds_read_tr16_b64_v4i16((LAS s16x4*)(vb + 16 * 288));
                    const bf16x8 vf = {a[0], a[1], a[2], a[3], b2[0], b2[1], b2[2], b2[3]};
                    ot[vi] = __builtin_amdgcn_mfma_f32_16x16x32_bf16(vf, pf[ph], ot[vi], 0, 0, 0); }
                ss += ot[vi][0] * ot[vi][0] + ot[vi][1] * ot[vi][1] + ot[vi][2] * ot[vi][2] + ot[vi][3] * ot[vi][3];
            }
            ss = xsum16_32(ss);
            if (g == 0) VEC[(10 + vh) * 128 + 16 * ti + fr] = ss;
            __syncthreads();
            {
                const float tot = VEC[10 * 128 + 16 * ti + fr] + VEC[11 * 128 + 16 * ti + fr];
                const float rs = rsqrtf(tot * (1.0f / 128.0f) + RMS_EPS);
                const size_t row = r0 + 16 * ti + fr;
                f32x4 gn[4]; u32x2 og[4];
#pragma unroll
                for (int vi = 0; vi < 4; ++vi) { const int v0 = 16 * (4 * vh + vi) + 4 * g; gn[vi] = *(const f32x4*)(p.hg_gnorm + v0); og[vi] = *(const u32x2*)(p.HOG + row * 1024 + h * 128 + v0); }
#pragma unroll
                for (int vi = 0; vi < 4; ++vi) { const int v0 = 16 * (4 * vh + vi) + 4 * g;
                    u32x2 wv; wv.x = cvt_pk_bf16(ot[vi][0] * rs * gn[vi][0] * lo_bf(og[vi].x), ot[vi][1] * rs * gn[vi][1] * hi_bf(og[vi].x)); wv.y = cvt_pk_bf16(ot[vi][2] * rs * gn[vi][2] * lo_bf(og[vi].y), ot[vi][3] * rs * gn[vi][3] * hi_bf(og[vi].y));
                    *(u32x2*)(p.OHG + row * 1024 + h * 128 + v0) = wv; }
            }
        }
        {
            float dk[4];
#pragma unroll
            for (int r = 0; r < 4; ++r) dk[r] = fast_exp(VEC[8 * 128 + 16 * w + 4 * g + r]);
#pragma unroll
            for (int vt = 0; vt < 8; ++vt)
#pragma unroll
                for (int r = 0; r < 4; ++r) sacc[vt][r] *= dk[r];
#pragma unroll
            for (int ks = 0; ks < 2; ++ks) {
                const LAS unsigned char* kb = KE + vt_byte<128>(32 * ks + 8 * g + (fr >> 2), 16 * w + 4 * (fr & 3));
                const s16x4 ka = __builtin_amdgcn_ds_read_tr16_b64_v4i16((LAS s16x4*)kb), kb2 = __builtin_amdgcn_ds_read_tr16_b64_v4i16((LAS s16x4*)(kb + 4 * 288));
                const bf16x8 kf = {ka[0], ka[1], ka[2], ka[3], kb2[0], kb2[1], kb2[2], kb2[3]};
#pragma unroll
                for (int vt = 0; vt < 8; ++vt) {
                    const LAS unsigned char* vb = VV + vt_byte<128>(32 * ks + 8 * g + (fr >> 2), 16 * vt + 4 * (fr & 3));
                    const s16x4 va = __builtin_amdgcn_ds_read_tr16_b64_v4i16((LAS s16x4*)vb), vb2 = __builtin_amdgcn_ds_read_tr16_b64_v4i16((LAS s16x4*)(vb + 4 * 288));
                    const bf16x8 vf = {va[0], va[1], va[2], va[3], vb2[0], vb2[1], vb2[2], vb2[3]};
                    sacc[vt] = __builtin_amdgcn_mfma_f32_16x16x32_bf16(kf, vf, sacc[vt], 0, 0, 0);
                }
            }
            if (!OUT && tid < 128) VEC[9 * 128 + tid] += VEC[8 * 128 + tid];
        }
        __syncthreads();
    }
    if (!OUT) {
        float* L = p.Lloc + (size_t)task * 16384;
#pragma unroll
        for (int vt = 0; vt < 8; ++vt)
#pragma unroll
            for (int r = 0; r < 4; ++r) L[(size_t)(16 * w + 4 * g + r) * 128 + 16 * vt + fr] = sacc[vt][r];
        if (tid < 128) p.Dec[(size_t)task * 128 + tid] = fast_exp(VEC[9 * 128 + tid]);
    }
}

__device__ __forceinline__ void hgrn_scan(const Params& p) {
    for (int e0 = (blockIdx.x * 512 + TID()) * 2; e0 < 16 * 16384; e0 += gridDim.x * 1024) {
        const int bh = e0 >> 14, kvx = e0 & 16383, k = kvx >> 7;
        f32x2 L[32]; float d[32];
#pragma unroll
        for (int sc = 0; sc < 32; ++sc) { const size_t task = (size_t)bh * 32 + sc; L[sc] = *(const f32x2*)(p.Lloc + task * 16384 + kvx); d[sc] = p.Dec[task * 128 + k]; }
        f32x2 S = (f32x2){0.f, 0.f};
#pragma unroll
        for (int sc = 0; sc < 32; ++sc) { const size_t task = (size_t)bh * 32 + sc; *(f32x2*)(p.Lloc + task * 16384 + kvx) = S; S = S * d[sc] + L[sc]; }
        *(f32x2*)(p.out + OFF_PSTATE + (size_t)bh * 16384 + kvx) = S;
    }
}

__device__ __forceinline__ void hgrn_sample_tasks(const Params& p, LAS unsigned char* lds) {
    const int tid = TID(), v = tid & 127, kq = tid >> 7;
    LAS float* FV = (LAS float*)(lds + 1024);
    LAS float* QV = FV + 1024;
    LAS float* PART = QV + 1024;
    float s[32], sn[32];
    int task = blockIdx.x;
    if (task < 1024) { const float* S0 = p.state_hgrn + ((size_t)task * 128 + kq * 32) * 128 + v;
#pragma unroll
        for (int j = 0; j < 32; ++j) sn[j] = S0[(size_t)j * 128]; }
    for (; task < 1024; task += gridDim.x) {
        const int b = task >> 3, h = task & 7;
#pragma unroll
        for (int j = 0; j < 32; ++j) s[j] = sn[j];
        const int nxt = task + gridDim.x;
        if (nxt < 1024) { const float* S0 = p.state_hgrn + ((size_t)nxt * 128 + kq * 32) * 128 + v;
#pragma unroll
            for (int j = 0; j < 32; ++j) sn[j] = S0[(size_t)j * 128]; }
        __syncthreads();
        for (int i = tid; i < 1024; i += 512) { const size_t row = (size_t)MP + b * 8 + (i >> 7); const int k = i & 127;
            FV[i] = fast_exp(p.G[row * 1024 + h * 128 + k]); QV[i] = bf2f(p.HQ[row * 1024 + h * 128 + k]); }
        __syncthreads();
#pragma unroll 1
        for (int i = 0; i < 8; ++i) {
            const size_t row = (size_t)MP + b * 8 + i;
            const float vv = bf2f(p.HV[row * 1024 + h * 128 + v]);
            float o = 0.f;
#pragma unroll
            for (int j = 0; j < 32; ++j) { const float f = FV[i * 128 + kq * 32 + j]; s[j] = f * s[j] + (1.0f - f) * vv; o += QV[i * 128 + kq * 32 + j] * s[j]; }
            PART[(kq * 8 + i) * 128 + v] = o;
        }
        float* S1 = p.out + OFF_SSTATE + ((size_t)task * 128 + kq * 32) * 128 + v;
#pragma unroll
        for (int j = 0; j < 32; ++j) S1[(size_t)j * 128] = s[j];
        __syncthreads();
        {
            const int i = tid >> 6, l = tid & 63;
            float o0 = 0.f, o1 = 0.f;
#pragma unroll
            for (int q = 0; q < 4; ++q) { o0 += PART[(q * 8 + i) * 128 + l]; o1 += PART[(q * 8 + i) * 128 + 64 + l]; }
            float ss = o0 * o0 + o1 * o1;
#pragma unroll
            for (int d = 1; d < 64; d <<= 1) ss += __shfl_xor(ss, d);
            const float rs = rsqrtf(ss * (1.0f / 128.0f) + RMS_EPS);
            const size_t row = (size_t)MP + b * 8 + i;
            p.OHG[row * 1024 + h * 128 + l] = f2bf(o0 * rs * p.hg_gnorm[l] * bf2f(p.HOG[row * 1024 + h * 128 + l]));
            p.OHG[row * 1024 + h * 128 + 64 + l] = f2bf(o1 * rs * p.hg_gnorm[64 + l] * bf2f(p.HOG[row * 1024 + h * 128 + 64 + l]));
        }
    }
}
constexpr float MEM_C = 0.0625f * 1.44269504088896f;
constexpr int X_KT = 1024;
constexpr int X_BUF = 32768 + 34816;
__device__ __forceinline__ void xattn_unit_prompt(const Params& p, int unit, LAS unsigned char* lds) {
    const int b = unit >> 8, head = (unit >> 6) & 3, qb = unit & 63;
    const int tid = TID(), lane = tid & 63, w = tid >> 6, fr = lane & 15, g = lane >> 4;
    AttnTile<256> T[1]; T[0].init();
    const size_t row = (size_t)b * SEQ + qb * 128 + 16 * w + fr;
#pragma unroll
    for (int ds = 0; ds < 8; ++ds) T[0].q[ds] = ldq_scaled(p.QM + row * 1024 + head * 256 + 32 * ds + 8 * g, MEM_C);
    u32x4 rk[4], rv[4];
    auto ld = [&](int kb) {
#pragma unroll
        for (int i = 0; i < 4; ++i) { const int c = tid + 512 * i, key = c >> 5, ch = c & 31; const bf16_t* src = p.MKVp + (size_t)(b * MEMT + kb * 64 + key) * 2048 + head * 256 + ch * 8; rk[i] = *(const u32x4*)src; rv[i] = *(const u32x4*)(src + 1024); } };
    auto st = [&](LAS unsigned char* buf) {
#pragma unroll
        for (int i = 0; i < 4; ++i) { const int c = tid + 512 * i, key = c >> 5, ch = c & 31; *(LAS u32x4*)(buf + ktile_byte<256>(key, ch * 8)) = rk[i]; *(LAS u32x4*)(buf + 32768 + key * vstride<256>() + ch * 16) = rv[i]; } };
    ld(0);
    __syncthreads();
    st(lds + X_KT);
    __syncthreads();
    for (int kb = 0; kb < 4; ++kb) {
        LAS unsigned char* buf = lds + X_KT + (kb & 1) * X_BUF;
        if (kb < 3) ld(kb + 1);
        attn_block1<256>(T[0], 0, buf, buf + 32768, MEM_C, false, [&](int, int) { return true; }, lane);
        if (kb < 3) st(lds + X_KT + ((kb + 1) & 1) * X_BUF);
        __syncthreads();
    }
    attn_store_bf16<256>(T[0], p.OM + row * 1024 + head * 256, lane);
}
__device__ __forceinline__ void xattn_unit_sample(const Params& p, int unit, LAS unsigned char* lds) {
    const int b = unit >> 2, head = unit & 3;
    const int tid = TID(), lane = tid & 63, w = tid >> 6, fr = lane & 15, g = lane >> 4;
    AttnTile<256> T[1]; T[0].init();
    const size_t row = (size_t)MP + b * 8 + (fr & 7);
#pragma unroll
    for (int ds = 0; ds < 8; ++ds) T[0].q[ds] = ldq_scaled(p.QM + row * 1024 + head * 256 + 32 * ds + 8 * g, MEM_C);
    u32x4 rk[4], rv[4];
    auto ld = [&](int kb) {
#pragma unroll
        for (int i = 0; i < 4; ++i) { const int c = tid + 512 * i, key = c >> 5, ch = c & 31; const float* src = p.cache_mem + (size_t)(b * MEMT + kb * 64 + key) * 2048 + head * 256 + ch * 8;
            rk[i] = pack8(*(const f32x4*)src, *(const f32x4*)(src + 4)); rv[i] = pack8(*(const f32x4*)(src + 1024), *(const f32x4*)(src + 1028)); } };
    auto st = [&](LAS unsigned char* buf) {
#pragma unroll
        for (int i = 0; i < 4; ++i) { const int c = tid + 512 * i, key = c >> 5, ch = c & 31; *(LAS u32x4*)(buf + ktile_byte<256>(key, ch * 8)) = rk[i]; *(LAS u32x4*)(buf + 32768 + key * vstride<256>() + ch * 16) = rv[i]; } };
    ld(0);
    __syncthreads();
    st(lds + X_KT);
    __syncthreads();
    for (int kb = 0; kb < 4; ++kb) {
        LAS unsigned char* buf = lds + X_KT + (kb & 1) * X_BUF;
        if (w == 0) attn_block1<256>(T[0], 0, buf, buf + 32768, MEM_C, false, [&](int, int) { return true; }, lane);
        else if (kb < 3) { ld(kb + 1); st(lds + X_KT + ((kb + 1) & 1) * X_BUF); }
        if (w == 0 && kb < 3) { ld(kb + 1); st(lds + X_KT + ((kb + 1) & 1) * X_BUF); }
        __syncthreads();
    }
    if (w == 0) {
        const int gg = lane >> 4; const float inv = 1.0f / fmaxf(xsum16_32(T[0].l), 1e-30f);
        if (fr < 8) {
#pragma unroll
            for (int dt = 0; dt < 16; ++dt) { u32x2 wv; wv.x = cvt_pk_bf16(T[0].o[dt][0] * inv, T[0].o[dt][1] * inv); wv.y = cvt_pk_bf16(T[0].o[dt][2] * inv, T[0].o[dt][3] * inv);
                *(u32x2*)(p.OM + row * 1024 + head * 256 + 16 * dt + 4 * gg) = wv; }
        }
    }
}

__device__ __forceinline__ void row_stats(const float* st, int row, float& mean, float& rstd) {
    const f32x2 s = *(const f32x2*)(st + (size_t)row * 2); mean = s.x * (1.0f / 1024.0f); const float var = fmaxf(s.y * (1.0f / 1024.0f) - mean * mean, 0.f); rstd = rsqrtf(var + LN_EPS);
}
struct EpiRes {
    static constexpr bool PERM = true, AFTER_DRAIN = false;
    int mode; const float* xp; const float* xs; const float* zprev; const float* stprev; const float* gain; const float* bias; float* Z; bf16_t* Zb; float* st;
    __device__ __forceinline__ void apply8(int row, int col, float mean, float rstd, const f32x4 a0, const f32x4 a1, float& s1, float& s2) const {
        const float* __restrict__ rsrc = (mode == 0) ? (row < MP ? xp + (size_t)row * 1024 : xs + (size_t)(row - MP) * 1024) : zprev + (size_t)row * 1024;
        const float* __restrict__ gn = gain; const float* __restrict__ bs = bias; float* __restrict__ Zo = Z; bf16_t* __restrict__ Zbo = Zb;
        f32x4 x0 = *(const f32x4*)(rsrc + col), x1 = *(const f32x4*)(rsrc + col + 4);
        if (mode == 1) { const f32x4 g0 = *(const f32x4*)(gn + col), g1 = *(const f32x4*)(gn + col + 4), b0 = *(const f32x4*)(bs + col), b1 = *(const f32x4*)(bs + col + 4);
            x0 = (x0 - mean) * rstd * g0 + b0; x1 = (x1 - mean) * rstd * g1 + b1; }
        const f32x4 z0 = x0 * DN_ALPHA + a0, z1 = x1 * DN_ALPHA + a1;
        float* d = Zo + (size_t)row * 1024 + col; *(f32x4*)d = z0; *(f32x4*)(d + 4) = z1;
        if (Zbo) *(u32x4*)(Zbo + (size_t)row * 1024 + col) = pack8(z0, z1);
#pragma unroll
        for (int j = 0; j < 4; ++j) { s1 += z0[j] + z1[j]; s2 += z0[j] * z0[j] + z1[j] * z1[j]; }
    }
    __device__ __forceinline__ void operator()(const f32x4 (&acc)[2][2][4][2], const pg8::Unit& u, int wr, int wc, int fr, int fq) const {
        float mean8[2][4], rstd8[2][4];
#pragma unroll
        for (int ai = 0; ai < 2; ++ai)
#pragma unroll
            for (int m = 0; m < 4; ++m) { mean8[ai][m] = 0.f; rstd8[ai][m] = 1.f; if (mode == 1) row_stats(stprev, u.pm * 256 + ai * 128 + wr * 64 + m * 16 + fr, mean8[ai][m], rstd8[ai][m]); }
#pragma unroll
        for (int ai = 0; ai < 2; ++ai)
#pragma unroll
            for (int m = 0; m < 4; ++m) {
                const int row = u.pm * 256 + ai * 128 + wr * 64 + m * 16 + fr;
                const float mean = mean8[ai][m], rstd = rstd8[ai][m];
                float s1 = 0.f, s2 = 0.f;
#pragma unroll
                for (int bj = 0; bj < 2; ++bj) apply8(row, u.pn * 256 + bj * 128 + wc * 32 + 8 * fq, mean, rstd, acc[ai][bj][m][0], acc[ai][bj][m][1], s1, s2);
                s1 = xsum16_32(s1); s2 = xsum16_32(s2);
                if (fq == 0) { atomicAdd(st + (size_t)row * 2, s1); atomicAdd(st + (size_t)row * 2 + 1, s2); }
            }
    }
    __device__ __forceinline__ void small(int row, int col, const f32x4 a0, const f32x4 a1, int t) const {
        float mean = 0.f, rstd = 1.f; if (mode == 1) row_stats(stprev, row, mean, rstd);
        float s1 = 0.f, s2 = 0.f; apply8(row, col, mean, rstd, a0, a1, s1, s2);
        s1 += __shfl_xor(s1, 1); s1 += __shfl_xor(s1, 2); s1 += __shfl_xor(s1, 4); s2 += __shfl_xor(s2, 1); s2 += __shfl_xor(s2, 2); s2 += __shfl_xor(s2, 4);
        if ((t & 7) == 0) { atomicAdd(st + (size_t)row * 2, s1); atomicAdd(st + (size_t)row * 2 + 1, s2); }
    }
};
struct EpiLnIn {
    static constexpr bool PERM = true, AFTER_DRAIN = false;
    int act; const float* st; const float* cs; const float* bw; bf16_t* O; int ldo;
    __device__ __forceinline__ void apply8(int row, int col, float mean, float rstd, const f32x4 a0, const f32x4 a1) const {
        const f32x4 c0 = *(const f32x4*)(cs + col), c1 = *(const f32x4*)(cs + col + 4), b0 = *(const f32x4*)(bw + col), b1 = *(const f32x4*)(bw + col + 4);
        f32x4 y0 = (a0 - c0 * mean) * rstd + b0, y1 = (a1 - c1 * mean) * rstd + b1;
        if (act == 1) {
#pragma unroll
            for (int j = 0; j < 4; ++j) { const float a = fmaxf(y0[j], 0.f), b2 = fmaxf(y1[j], 0.f); y0[j] = a * a; y1[j] = b2 * b2; } }
        *(u32x4*)(O + (size_t)row * ldo + col) = pack8(y0, y1);
    }
    __device__ __forceinline__ void operator()(const f32x4 (&acc)[2][2][4][2], const pg8::Unit& u, int wr, int wc, int fr, int fq) const {
#pragma unroll
        for (int ai = 0; ai < 2; ++ai)
#pragma unroll
            for (int m = 0; m < 4; ++m) {
                const int row = u.pm * 256 + ai * 128 + wr * 64 + m * 16 + fr;
                float mean, rstd; row_stats(st, row, mean, rstd);
#pragma unroll
                for (int bj = 0; bj < 2; ++bj) apply8(row, u.pn * 256 + bj * 128 + wc * 32 + 8 * fq, mean, rstd, acc[ai][bj][m][0], acc[ai][bj][m][1]);
            }
    }
    __device__ __forceinline__ void small(int row, int col, const f32x4 a0, const f32x4 a1, int) const { float mean, rstd; row_stats(st, row, mean, rstd); apply8(row, col, mean, rstd, a0, a1); }
};
template <class Epi> __device__ __forceinline__ void small_gemm(LAS unsigned char* lds, const bf16_t* A, int lda, const bf16_t* Bt, int K, int rowbase, int nrt, int nct, const Epi& E) {
    const int tid = TID(), lane = tid & 63, w = tid >> 6, fr = lane & 15, g = lane >> 4;
    LAS float* red = (LAS float*)lds;
    const int kw = K >> 3;
    for (int tile = blockIdx.x; tile < nrt * nct; tile += gridDim.x) {
        const int row0 = rowbase + (tile / nct) * 64, col0 = (tile % nct) * 64;
        f32x4 acc[4][4];
#pragma unroll
        for (int mt = 0; mt < 4; ++mt)
#pragma unroll
            for (int nt = 0; nt < 4; ++nt) acc[mt][nt] = (f32x4){0.f, 0.f, 0.f, 0.f};
        const bf16_t* ap = A + (size_t)(row0 + fr) * lda + (size_t)w * kw + 8 * g;
        const bf16_t* bp = Bt + (size_t)(col0 + fr) * K + (size_t)w * kw + 8 * g;
        bf16x8 af[4][4], bfr[4][4];
#pragma unroll
        for (int st = 0; st < 4; ++st)
#pragma unroll
            for (int mt = 0; mt < 4; ++mt) { af[st][mt] = *(const bf16x8*)(ap + (size_t)(16 * mt) * lda + 32 * st); bfr[st][mt] = *(const bf16x8*)(bp + (size_t)(16 * mt) * K + 32 * st); }
        for (int k0 = 0; k0 < kw; k0 += 128) {
#pragma unroll
            for (int st = 0; st < 4; ++st) {
#pragma unroll
                for (int mt = 0; mt < 4; ++mt)
#pragma unroll
                    for (int nt = 0; nt < 4; ++nt) acc[mt][nt] = __builtin_amdgcn_mfma_f32_16x16x32_bf16(bfr[st][nt], af[st][mt], acc[mt][nt], 0, 0, 0);
                if (k0 + 128 < kw) {
#pragma unroll
                    for (int mt = 0; mt < 4; ++mt) { af[st][mt] = *(const bf16x8*)(ap + (size_t)(16 * mt) * lda + k0 + 128 + 32 * st); bfr[st][mt] = *(const bf16x8*)(bp + (size_t)(16 * mt) * K + k0 + 128 + 32 * st); }
                }
            }
        }
        __syncthreads();
#pragma unroll
        for (int mt = 0; mt < 4; ++mt)
#pragma unroll
            for (int nt = 0; nt < 4; ++nt) *(LAS f32x4*)(red + ((size_t)w * 64 + 16 * mt + fr) * 68 + 16 * nt + 4 * g) = acc[mt][nt];
        __syncthreads();
        {
            const int r = tid >> 3, c8 = (tid & 7) * 8;
            f32x4 s0 = (f32x4){0.f, 0.f, 0.f, 0.f}, s1 = s0;
#pragma unroll
            for (int ww = 0; ww < 8; ++ww) { const LAS float* q = red + ((size_t)ww * 64 + r) * 68 + c8; s0 += *(const LAS f32x4*)q; s1 += *(const LAS f32x4*)(q + 4); }
            E.small(row0 + r, col0 + c8, s0, s1, tid);
        }
    }
    __syncthreads();
}
template <class Epi> __device__ __forceinline__ void run_gemm(LAS unsigned char* lds, const bf16_t* A, int lda, const bf16_t* Bt, int M, int N, int K, const Epi& E) {
    pg8::Gemm g{A, Bt, M, N, K, lda};
    pg8::StaticOrder S; S.init(M, N, gridDim.x, blockIdx.x);
    pg8::gemm_phase<Epi, pg8::StaticOrder, false>(lds, g, S, E, nullptr);
}
__device__ __forceinline__ void phase_gemm1_small(const Params& p, LAS unsigned char* lds) {
    Epi1Small E0{0, &p};
    small_gemm(lds, p.Xb, DM, p.Wt_in + (size_t)26 * 256 * 1024, DM, 0, MT / 64, 1, E0);
    Epi1Small E1{1, &p};
    small_gemm(lds, p.Xb, DM, p.Wt_in + (size_t)33 * 256 * 1024, DM, MP, MS / 64, 512 / 64, E1);
}
__device__ __forceinline__ void final_ln(const Params& p) {
    const int lane = TID() & 63, gw = blockIdx.x * 8 + (TID() >> 6), nw = gridDim.x * 8;
    const float* gain = p.ln_g + 2048; const float* bias = p.ln_b + 2048;
    f32x4 g4[4], b4[4];
#pragma unroll
    for (int i = 0; i < 4; ++i) { const int c = (i * 64 + lane) * 4; g4[i] = *(const f32x4*)(gain + c); b4[i] = *(const f32x4*)(bias + c); }
    for (int row0 = gw; row0 < MT; row0 += 4 * nw) {
        f32x4 v[4][4]; float mean[4], rstd[4];
#pragma unroll
        for (int u = 0; u < 4; ++u) { const int row = row0 + u * nw; if (row < MT) { row_stats(p.stats3, row, mean[u], rstd[u]); const float* z = p.out + (size_t)row * 1024;
#pragma unroll
            for (int i = 0; i < 4; ++i) v[u][i] = *(const f32x4*)(z + (i * 64 + lane) * 4); } }
#pragma unroll
        for (int u = 0; u < 4; ++u) { const int row = row0 + u * nw; if (row < MT) { float* z = p.out + (size_t)row * 1024;
#pragma unroll
            for (int i = 0; i < 4; ++i) *(f32x4*)(z + (i * 64 + lane) * 4) = (v[u][i] - mean[u]) * rstd[u] * g4[i] + b4[i]; } }
    }
}

__device__ __forceinline__ int balanced_unit(int L) { const int i = L / (int)gridDim.x, q = L & 127; return (L & ~127) | ((i & 1) ? 127 - q : q); }
__device__ __forceinline__ void phase_mix1(const Params& p, LAS unsigned char* lds) {
    const bool sfirst = (blockIdx.x & 1) != 0;
    phase_gemm1_small(p, lds);
    {
        EpiPlain E{p.out + OFF_PMEM, 2048, p.MKVp, 2048};
        small_gemm(lds, p.Memb, DM, p.Wt_mkv, DM, 0, NBATCH * MEMT / 64, 2048 / 64, E);
    }
    {
        if (sfirst) for (int u = blockIdx.x; u < 512; u += gridDim.x) cmp_gemm_sample_unit(p, u, lds);
        EpiCmp E{(bf16_t*)p.CCp};
        small_gemm(lds, p.CKp, 1024, p.W1t, 1024, 0, 4096 / 64, 256 / 64, E);
        EpiCmp E2{(bf16_t*)p.CCp + (size_t)69632 * 256};
        small_gemm(lds, p.CVp, 1024, p.W1t + (size_t)256 * 1024, 1024, 0, 4096 / 64, 256 / 64, E2);
    }
    if (sfirst) { for (int u = blockIdx.x; u < 512; u += gridDim.x) win_unit_sample(p, u, lds); hgrn_sample_tasks(p, lds); }
    for (int u = blockIdx.x; u < 1024; u += gridDim.x) win_unit_prompt(p, u, lds);
    for (int t = blockIdx.x; t < 512; t += gridDim.x) hgrn_task<false>(p, t, lds);
    if (!sfirst) { for (int u = blockIdx.x; u < 512; u += gridDim.x) cmp_gemm_sample_unit(p, u, lds);
        for (int u = blockIdx.x; u < 512; u += gridDim.x) win_unit_sample(p, u, lds); hgrn_sample_tasks(p, lds); }
}
__device__ __forceinline__ void phase_mix2(const Params& p, LAS unsigned char* lds) { hgrn_scan(p); cmp_stage2(p); }
__device__ __forceinline__ void phase_mix3(const Params& p, LAS unsigned char* lds) {
    for (int t = blockIdx.x; t < 512; t += gridDim.x) hgrn_task<true>(p, t, lds);
    for (int u = blockIdx.x; u < 1024; u += gridDim.x) cmp_unit(p, false, balanced_unit(u), lds);
    for (int u = blockIdx.x; u < 512; u += gridDim.x) cmp_unit(p, true, u, lds);
}
__device__ __forceinline__ void phase_slc(const Params& p, LAS unsigned char* lds) {
    const int c = blockIdx.x, G = gridDim.x; const bool sfirst = (c & 1) != 0;
    if (sfirst) for (int u = c; u < 512; u += G) slc_unit_sample(p, u, lds);
    if (G == 256) { const int bkv = c & 7, m = c >> 3;
        for (int i = 0; i < 4; ++i) { const int qt = (i == 0) ? m : (i == 1) ? 63 - m : (i == 2) ? 64 + m : 127 - m; slc_unit_prompt_ring(p, bkv * 128 + qt, lds); } }
    else for (int u = c; u < 1024; u += G) slc_unit_prompt_ring(p, balanced_unit(u), lds);
    if (!sfirst) for (int u = c; u < 512; u += G) slc_unit_sample(p, u, lds);
}
__device__ __forceinline__ void phase_wout(const Params& p, LAS unsigned char* lds) {
    EpiRes E{0, p.x_prompt, p.x_sample, nullptr, nullptr, nullptr, nullptr, p.Z1, p.Z1b, p.stats1};
    run_gemm(lds, p.MERGED, DM, p.Wt_out, MP, DM, DM, E);
    small_gemm(lds, p.MERGED, DM, p.Wt_out, DM, MP, MS / 64, DM / 64, E);
}
__device__ __forceinline__ void phase_mq(const Params& p, LAS unsigned char* lds) {
    EpiLnIn E{0, p.stats1, p.cs_mq, p.bw_mq, p.QM, 1024};
    run_gemm(lds, p.Z1b, DM, p.Wt_mq, MP, DM, DM, E);
    small_gemm(lds, p.Z1b, DM, p.Wt_mq, DM, MP, MS / 64, DM / 64, E);
}
__device__ __forceinline__ void phase_xattn(const Params& p, LAS unsigned char* lds) {
    if (blockIdx.x & 1) for (int u = blockIdx.x; u < 512; u += gridDim.x) xattn_unit_sample(p, u, lds);
    for (int u = blockIdx.x; u < 512; u += gridDim.x) xattn_unit_prompt(p, u, lds);
    if (!(blockIdx.x & 1)) for (int u = blockIdx.x; u < 512; u += gridDim.x) xattn_unit_sample(p, u, lds);
}
__device__ __forceinline__ void phase_mo(const Params& p, LAS unsigned char* lds) {
    EpiRes E{1, nullptr, nullptr, p.Z1, p.stats1, p.ln_g, p.ln_b, p.Z2, p.Z2b, p.stats2};
    run_gemm(lds, p.OM, DM, p.Wt_mo, MP, DM, DM, E);
    small_gemm(lds, p.OM, DM, p.Wt_mo, DM, MP, MS / 64, DM / 64, E);
}
__device__ __forceinline__ void phase_up(const Params& p, LAS unsigned char* lds) {
    EpiLnIn E{1, p.stats2, p.cs_up, p.bw_up, p.Hb, DFF};
    run_gemm(lds, p.Z2b, DM, p.Wt_up, MP, DFF, DM, E);
    small_gemm(lds, p.Z2b, DM, p.Wt_up, DM, MP, MS / 64, DFF / 64, E);
}
__device__ __forceinline__ void phase_down(const Params& p, LAS unsigned char* lds) {
    EpiRes E{1, nullptr, nullptr, p.Z2, p.stats2, p.ln_g + 1024, p.ln_b + 1024, p.out, nullptr, p.stats3};
    run_gemm(lds, p.Hb, DFF, p.Wt_down, MP, DM, DFF, E);
    small_gemm(lds, p.Hb, DFF, p.Wt_down, DFF, MP, MS / 64, DM / 64, E);
}
constexpr int LDS_BYTES = 160 * 1024;
constexpr int NTHREADS = 512;

template <int PH> __device__ __forceinline__ void run_phase(const Params& p, LAS unsigned char* lds) {
    if constexpr (PH == 0) phase_prologue(p, lds);
    else if constexpr (PH == 1) phase_gemm1(p, lds);
    else if constexpr (PH == 2) phase_mix1(p, lds);
    else if constexpr (PH == 3) phase_mix2(p, lds);
    else if constexpr (PH == 4) phase_mix3(p, lds);
    else if constexpr (PH == 5) phase_slc(p, lds);
    else if constexpr (PH == 6) phase_wout(p, lds);
    else if constexpr (PH == 7) phase_mq(p, lds);
    else if constexpr (PH == 8) phase_xattn(p, lds);
    else if constexpr (PH == 9) phase_mo(p, lds);
    else if constexpr (PH == 10) phase_up(p, lds);
    else if constexpr (PH == 11) phase_down(p, lds);
    else if constexpr (PH == 12) final_ln(p);
}

template <int PH> __global__ void __launch_bounds__(NTHREADS, 2) k_phase(Params p) {
    extern __shared__ __attribute__((aligned(16))) unsigned char smem[];
    run_phase<PH>(p, (LAS unsigned char*)smem);
}


__global__ void __launch_bounds__(NTHREADS, 2) k_mega(Params p) {
    extern __shared__ __attribute__((aligned(16))) unsigned char smem[];
    LAS unsigned char* lds = (LAS unsigned char*)smem;
    volatile LAS unsigned* xbw = (volatile LAS unsigned*)(lds + LDS_BYTES - 16);
    if (TID() == 0) { xbw[0] = 0u; xbw[1] = 0u; }
    __syncthreads();
    XcdBarrier bar = xcd_barrier_post(p.bar, xbw);
    run_phase<0>(p, lds);  xcd_barrier(bar);
    run_phase<1>(p, lds);  xcd_barrier(bar);
    run_phase<2>(p, lds);  xcd_barrier(bar);
    run_phase<3>(p, lds);  xcd_barrier(bar);
    run_phase<4>(p, lds);  xcd_barrier(bar);
    run_phase<5>(p, lds);  xcd_barrier(bar);
    run_phase<6>(p, lds);  xcd_barrier(bar);
    run_phase<7>(p, lds);  xcd_barrier(bar);
    run_phase<8>(p, lds);  xcd_barrier(bar);
    run_phase<9>(p, lds);  xcd_barrier(bar);
    run_phase<10>(p, lds); xcd_barrier(bar);
    run_phase<11>(p, lds); xcd_barrier(bar);
    run_phase<12>(p, lds);
}

struct WsAlloc { char* base; size_t off; template <class T> T* get(size_t n) { T* r = (T*)(base + off); off += (n * sizeof(T) + 255) & ~(size_t)255; return r; } };

template <int PH> static void launch_phase(const Params& p, hipStream_t stream) {
    static bool attr = false;
    if (!attr) { (void)hipFuncSetAttribute((const void*)k_phase<PH>, hipFuncAttributeMaxDynamicSharedMemorySize, LDS_BYTES); attr = true; }
    hipLaunchKernelGGL(k_phase<PH>, dim3(256), dim3(NTHREADS), LDS_BYTES, stream, p);
}

extern "C" void kernel_launch(void* const* d_in, const int* in_sizes, int n_in, void* d_out, int out_size, void* d_ws, size_t ws_size, hipStream_t stream) {
    Params p{};
    p.x_prompt = (const float*)d_in[0]; p.x_sample = (const float*)d_in[1]; p.state_hgrn = (const float*)d_in[2]; p.cache_cmp = (const float*)d_in[3];
    p.cache_slc = (const float*)d_in[4]; p.cache_win = (const float*)d_in[5]; p.cache_mem = (const float*)d_in[6]; p.page_table = (const int*)d_in[7];
    p.mem_prompt = (const float*)d_in[8]; p.w_in = (const float*)d_in[9]; p.w_out = (const float*)d_in[10]; p.hg_lb = (const float*)d_in[11];
    p.hg_gnorm = (const float*)d_in[12]; p.cmp_pe = (const float*)d_in[13]; p.cmp_w1 = (const float*)d_in[14]; p.cmp_w2 = (const float*)d_in[15];
    p.w_mq = (const float*)d_in[16]; p.w_mkv = (const float*)d_in[17]; p.w_mo = (const float*)d_in[18]; p.w_up = (const float*)d_in[19];
    p.w_down = (const float*)d_in[20]; p.ln_g = (const float*)d_in[21]; p.ln_b = (const float*)d_in[22];
    p.out = (float*)d_out;
    WsAlloc W{(char*)d_ws, 0};
    p.bar = W.get<unsigned>(4096); p.stats1 = W.get<float>((size_t)MT * 2); p.stats2 = W.get<float>((size_t)MT * 2); p.stats3 = W.get<float>((size_t)MT * 2);
    p.cs_mq = W.get<float>(1024); p.bw_mq = W.get<float>(1024); p.cs_up = W.get<float>(4096); p.bw_up = W.get<float>(4096); p.posb = W.get<float>(256);
    const size_t zero_bytes = W.off;
    p.Wt_in = W.get<bf16_t>((size_t)NINP * DM); p.Wt_out = W.get<bf16_t>((size_t)DM * DM); p.Wt_mq = W.get<bf16_t>((size_t)DM * DM); p.Wt_mkv = W.get<bf16_t>((size_t)2 * DM * DM);
    p.Wt_mo = W.get<bf16_t>((size_t)DM * DM); p.Wt_up = W.get<bf16_t>((size_t)DFF * DM); p.Wt_down = W.get<bf16_t>((size_t)DM * DFF);
    p.W1t = W.get<bf16_t>((size_t)2 * 256 * 1024); p.W2t = W.get<bf16_t>((size_t)2 * 64 * 128);
    p.lbv = W.get<float>(1024); p.rope = W.get<float>((size_t)SEQ * 64);
    p.Xb = W.get<bf16_t>((size_t)MT * DM); p.Memb = W.get<bf16_t>((size_t)NBATCH * MEMT * DM);
    p.HQ = W.get<bf16_t>((size_t)MT * DM); p.HV = W.get<bf16_t>((size_t)MT * DM); p.HOG = W.get<bf16_t>((size_t)MT * DM); p.QN = W.get<bf16_t>((size_t)MT * DM);
    p.QR = W.get<bf16_t>((size_t)MT * DM); p.GA = W.get<bf16_t>((size_t)MT * DM); p.GB = W.get<bf16_t>((size_t)MT * DM);
    p.G = W.get<float>((size_t)MT * DM); p.NG = W.get<float>((size_t)MT * 48);
    p.CKp = W.get<bf16_t>((size_t)4 * MP * 64); p.CKs = W.get<bf16_t>((size_t)4 * DBATCH * PAST * 64);
    p.CVp = W.get<bf16_t>((size_t)4 * MP * 64); p.CVs = W.get<bf16_t>((size_t)4 * DBATCH * PAST * 64);
    p.SKp = W.get<bf16_t>((size_t)4 * MP * 64); p.SVp = W.get<bf16_t>((size_t)4 * MP * 64); p.WKp = W.get<bf16_t>((size_t)4 * MP * 64); p.WVp = W.get<bf16_t>((size_t)4 * MP * 64);
    p.SKs = W.get<bf16_t>((size_t)4 * MS * 64); p.SVs = W.get<bf16_t>((size_t)4 * MS * 64); p.WKs = W.get<bf16_t>((size_t)4 * MS * 64); p.WVs = W.get<bf16_t>((size_t)4 * MS * 64);
    p.MKVp = W.get<bf16_t>((size_t)NBATCH * MEMT * 2048);
    p.CCp = W.get<float>((size_t)2 * 4096 * 256); p.CCs = W.get<float>((size_t)2 * 65536 * 256);
    p.KCp = W.get<bf16_t>((size_t)NBATCH * 4 * 512 * 64); p.VCp = W.get<bf16_t>((size_t)NBATCH * 4 * 512 * 64);
    p.KCs = W.get<bf16_t>((size_t)DBATCH * 4 * 128 * 64); p.VCs = W.get<bf16_t>((size_t)DBATCH * 4 * 128 * 64);
    p.Lloc = W.get<float>((size_t)512 * 128 * 128); p.Dec = W.get<float>((size_t)512 * 128); p.Sst = W.get<bf16_t>((size_t)512 * 128 * 128);
    p.OHG = W.get<bf16_t>((size_t)MT * DM); p.OWIN = W.get<bf16_t>((size_t)MT * DM); p.OCMP = W.get<bf16_t>((size_t)MT * DM); p.MERGED = W.get<bf16_t>((size_t)MT * DM);
    p.SEL = W.get<unsigned>((size_t)MT * 16);
    p.Z1 = W.get<float>((size_t)MT * DM); p.Z2 = W.get<float>((size_t)MT * DM); p.Z1b = W.get<bf16_t>((size_t)MT * DM); p.Z2b = W.get<bf16_t>((size_t)MT * DM);
    p.QM = W.get<bf16_t>((size_t)MT * DM); p.OM = W.get<bf16_t>((size_t)MT * DM); p.Hb = W.get<bf16_t>((size_t)MT * DFF);
    if (W.off > ws_size) { fprintf(stderr, "workspace too small: need %zu have %zu\n", W.off, ws_size); return; }
    (void)hipMemsetAsync(d_ws, 0, zero_bytes, stream);
#if defined(MK_MULTI)
    launch_phase<0>(p, stream); launch_phase<1>(p, stream); launch_phase<2>(p, stream); launch_phase<3>(p, stream); launch_phase<4>(p, stream);
    launch_phase<5>(p, stream); launch_phase<6>(p, stream); launch_phase<7>(p, stream); launch_phase<8>(p, stream); launch_phase<9>(p, stream);
    launch_phase<10>(p, stream); launch_phase<11>(p, stream); launch_phase<12>(p, stream);
#else
    static int grid = 0;
    if (!grid) {
        int dev = 0, cus = 0, per_cu = 0;
        (void)hipGetDevice(&dev); (void)hipDeviceGetAttribute(&cus, hipDeviceAttributeMultiprocessorCount, dev);
        (void)hipFuncSetAttribute((const void*)k_mega, hipFuncAttributeMaxDynamicSharedMemorySize, LDS_BYTES);
        (void)hipOccupancyMaxActiveBlocksPerMultiprocessor(&per_cu, (const void*)k_mega, NTHREADS, LDS_BYTES);
        if (per_cu < 1) { fprintf(stderr, "k_mega does not fit on a CU\n"); return; }
        grid = cus;
    }
    hipLaunchKernelGGL(k_mega, dim3(grid), dim3(NTHREADS), LDS_BYTES, stream, p);
#endif
}
```
